# Optimizing an MI355X kernel written in HIP

```python
import math
import jax, jax.numpy as jnp
from jax import lax
import numpy as np

D_MODEL = 1024
BATCH = 4
SEQ = 4096
DEPTH = 1

HEAD_DIM = 64
N_DIFF_HEADS = 8
DIFF_QK_DIM = HEAD_DIM // 2
DIFF_WIDTH = N_DIFF_HEADS * HEAD_DIM
N_SGU_HEADS = 8
SGU_WIDTH = N_SGU_HEADS * HEAD_DIM
MIX_WIDTH = DIFF_WIDTH + SGU_WIDTH
IN_COLS = 3 * DIFF_WIDTH + 2 * SGU_WIDTH
SGU_CHUNK = 128
Q_BLOCK = 128
ROPE_THETA = 10000.0
PEER_HEADS = 8
PEER_N_KEYS = 128
PEER_N_EXPERTS = PEER_N_KEYS * PEER_N_KEYS
PEER_TOPK = 16
PEER_QUERY_DIM = 256
PEER_HALF = PEER_QUERY_DIM // 2
PEER_CHUNK = 128
NORM_EPS = 1e-6
LN_EPS = 1e-5

kernel_name = 'hymba_diffattn_sgu_peer_block'


def rmsnorm(x, w):
    xf = x.astype(jnp.float32)
    y = xf * lax.rsqrt(jnp.mean(xf * xf, axis=-1, keepdims=True) + NORM_EPS)
    return (y * w.astype(jnp.float32)).astype(x.dtype)


def layernorm(x, w, b):
    xf = x.astype(jnp.float32)
    mu = jnp.mean(xf, axis=-1, keepdims=True)
    xc = xf - mu
    y = xc * lax.rsqrt(jnp.mean(xc * xc, axis=-1, keepdims=True) + LN_EPS)
    return (y * w.astype(jnp.float32) + b.astype(jnp.float32)).astype(x.dtype)


def apply_rope(t, cos, sin):
    half = t.shape[-1] // 2
    t1, t2 = t[..., :half], t[..., half:]
    return jnp.concatenate([t1 * cos - t2 * sin, t2 * cos + t1 * sin], axis=-1)


def diff_attention(q1, q2, k1, k2, v, lam):
    B, H, S, d = q1.shape
    nb = S // Q_BLOCK
    scale = d ** -0.5
    q1b = q1.reshape(B, H, nb, Q_BLOCK, d).transpose(2, 0, 1, 3, 4)
    q2b = q2.reshape(B, H, nb, Q_BLOCK, d).transpose(2, 0, 1, 3, 4)
    starts = jnp.arange(nb, dtype=jnp.int32) * Q_BLOCK
    kpos = jnp.arange(S, dtype=jnp.int32)

    def one_block(args):
        qa, qb, start = args
        qpos = start + jnp.arange(Q_BLOCK, dtype=jnp.int32)
        mask = kpos[None, :] <= qpos[:, None]
        s1 = jnp.einsum('bhqd,bhkd->bhqk', qa, k1).astype(jnp.float32) * scale
        s2 = jnp.einsum('bhqd,bhkd->bhqk', qb, k2).astype(jnp.float32) * scale
        p1 = jax.nn.softmax(jnp.where(mask, s1, -jnp.inf), axis=-1)
        p2 = jax.nn.softmax(jnp.where(mask, s2, -jnp.inf), axis=-1)
        a = (p1 - lam * p2).astype(v.dtype)
        return jnp.einsum('bhqk,bhkd->bhqd', a, v)

    out = lax.map(one_block, (q1b, q2b, starts))
    return out.transpose(1, 0, 3, 2, 4).reshape(B, S, H, v.shape[-1])


def spatial_gating(u, vg, ln_w, ln_b, ws, sb):
    B, S, _ = u.shape
    nc = S // SGU_CHUNK
    vg = layernorm(vg, ln_w, ln_b).reshape(B, nc, SGU_CHUNK, N_SGU_HEADS, HEAD_DIM)
    causal = jnp.tril(jnp.ones((SGU_CHUNK, SGU_CHUNK), dtype=bool))
    w = jnp.where(causal[None], ws, jnp.zeros_like(ws))
    mixed = jnp.einsum('hts,bcshd->bcthd', w, vg) + sb.T[None, None, :, :, None]
    out = u.reshape(B, nc, SGU_CHUNK, N_SGU_HEADS, HEAD_DIM) * mixed
    return out.reshape(B, S, N_SGU_HEADS, HEAD_DIM)


def peer_ffn(x, wq, keys, u_tab, v_tab):
    B, S, D = x.shape
    T = B * S
    xt = x.reshape(T, D)
    q = (xt @ wq).reshape(T, PEER_HEADS, 2, PEER_HALF)
    s1 = jnp.einsum('thd,nd->thn', q[:, :, 0], keys[0]).astype(jnp.float32)
    s2 = jnp.einsum('thd,nd->thn', q[:, :, 1], keys[1]).astype(jnp.float32)
    v1, i1 = lax.top_k(s1, PEER_TOPK)
    v2, i2 = lax.top_k(s2, PEER_TOPK)
    cand = (v1[..., :, None] + v2[..., None, :]).reshape(T, PEER_HEADS, PEER_TOPK * PEER_TOPK)
    sc, ci = lax.top_k(cand, PEER_TOPK)
    e1 = jnp.take_along_axis(i1, ci // PEER_TOPK, axis=-1)
    e2 = jnp.take_along_axis(i2, ci % PEER_TOPK, axis=-1)
    idx = e1 * PEER_N_KEYS + e2
    g = jax.nn.softmax(sc, axis=-1)
    nch = T // PEER_CHUNK

    def one_chunk(args):
        xc, ic, gc = args
        uc = jnp.take(u_tab, ic, axis=0)
        act = jax.nn.gelu(jnp.einsum('chkd,cd->chk', uc, xc).astype(jnp.float32), approximate=False)
        coef = (gc * act).astype(xc.dtype)
        vc = jnp.take(v_tab, ic, axis=0)
        return jnp.einsum('chk,chkd->cd', coef, vc)

    y = lax.map(one_chunk, (xt.reshape(nch, PEER_CHUNK, D),
                            idx.reshape(nch, PEER_CHUNK, PEER_HEADS, PEER_TOPK),
                            g.reshape(nch, PEER_CHUNK, PEER_HEADS, PEER_TOPK)))
    return y.reshape(B, S, D)


def setup_inputs(seed: int = 0) -> dict:
    key = jax.random.key(seed)
    ks = jax.random.split(key, 24)
    f32 = jnp.float32
    nrm = lambda k, shape, s: jax.random.normal(k, shape, f32) * s
    gain = lambda k, shape: 1.0 + 0.02 * jax.random.normal(k, shape, f32)
    return {
        'x': jax.random.normal(ks[0], (BATCH, SEQ, D_MODEL), f32),
        'attn_norm_w': gain(ks[1], (DEPTH, D_MODEL)),
        'w_in': nrm(ks[2], (DEPTH, D_MODEL, IN_COLS), D_MODEL ** -0.5),
        'lambda_q1': nrm(ks[3], (DEPTH, DIFF_QK_DIM), 0.1),
        'lambda_k1': nrm(ks[4], (DEPTH, DIFF_QK_DIM), 0.1),
        'lambda_q2': nrm(ks[5], (DEPTH, DIFF_QK_DIM), 0.1),
        'lambda_k2': nrm(ks[6], (DEPTH, DIFF_QK_DIM), 0.1),
        'subln_w': gain(ks[7], (DEPTH, HEAD_DIM)),
        'sgu_ln_w': gain(ks[8], (DEPTH, SGU_WIDTH)),
        'sgu_ln_b': nrm(ks[9], (DEPTH, SGU_WIDTH), 0.02),
        'sgu_ws': nrm(ks[10], (DEPTH, N_SGU_HEADS, SGU_CHUNK, SGU_CHUNK), SGU_CHUNK ** -0.5),
        'sgu_b': gain(ks[11], (DEPTH, N_SGU_HEADS, SGU_CHUNK)),
        'sgu_out_norm_w': gain(ks[12], (DEPTH, SGU_WIDTH)),
        'w_out': nrm(ks[13], (DEPTH, MIX_WIDTH, D_MODEL), MIX_WIDTH ** -0.5),
        'ffn_norm_w': gain(ks[14], (DEPTH, D_MODEL)),
        'peer_wq': nrm(ks[15], (DEPTH, D_MODEL, PEER_HEADS * PEER_QUERY_DIM), D_MODEL ** -0.5),
        'peer_keys': nrm(ks[16], (DEPTH, 2, PEER_N_KEYS, PEER_HALF), PEER_HALF ** -0.5),
        'peer_u': nrm(ks[17], (DEPTH, PEER_N_EXPERTS, D_MODEL), D_MODEL ** -0.5),
        'peer_v': nrm(ks[18], (DEPTH, PEER_N_EXPERTS, D_MODEL), 0.5),
        'final_norm_w': gain(ks[19], (D_MODEL,)),
    }


def reference(x, attn_norm_w, w_in, lambda_q1, lambda_k1, lambda_q2, lambda_k2, subln_w,
              sgu_ln_w, sgu_ln_b, sgu_ws, sgu_b, sgu_out_norm_w, w_out, ffn_norm_w,
              peer_wq, peer_keys, peer_u, peer_v, final_norm_w):
    B, S, _ = x.shape
    pos = jnp.arange(S, dtype=jnp.float32)
    inv_freq = ROPE_THETA ** (-jnp.arange(0, DIFF_QK_DIM, 2, dtype=jnp.float32) / DIFF_QK_DIM)
    ang = pos[:, None] * inv_freq[None, :]
    cos = jnp.cos(ang).astype(x.dtype)
    sin = jnp.sin(ang).astype(x.dtype)
    splits = [DIFF_WIDTH, 2 * DIFF_WIDTH, 3 * DIFF_WIDTH, 3 * DIFF_WIDTH + SGU_WIDTH]
    for l in range(DEPTH):
        h = rmsnorm(x, attn_norm_w[l])
        proj = h @ w_in[l]
        q, k, v, zu, zv = jnp.split(proj, splits, axis=-1)
        q = apply_rope(q.reshape(B, S, N_DIFF_HEADS, 2, DIFF_QK_DIM).transpose(0, 2, 3, 1, 4), cos, sin)
        k = apply_rope(k.reshape(B, S, N_DIFF_HEADS, 2, DIFF_QK_DIM).transpose(0, 2, 3, 1, 4), cos, sin)
        v = v.reshape(B, S, N_DIFF_HEADS, HEAD_DIM).transpose(0, 2, 1, 3)
        lam_init = 0.8 - 0.6 * math.exp(-0.3 * l)
        lam = (jnp.exp(jnp.sum(lambda_q1[l] * lambda_k1[l]).astype(jnp.float32))
               - jnp.exp(jnp.sum(lambda_q2[l] * lambda_k2[l]).astype(jnp.float32)) + lam_init)
        attn = diff_attention(q[:, :, 0], q[:, :, 1], k[:, :, 0], k[:, :, 1], v, lam)
        attn = (rmsnorm(attn, subln_w[l]) * (1.0 - lam_init)).reshape(B, S, DIFF_WIDTH)
        sgu = spatial_gating(jax.nn.gelu(zu, approximate=False), jax.nn.gelu(zv, approximate=False),
                             sgu_ln_w[l], sgu_ln_b[l], sgu_ws[l], sgu_b[l])
        sgu = rmsnorm(sgu, sgu_out_norm_w[l].reshape(N_SGU_HEADS, HEAD_DIM)).reshape(B, S, SGU_WIDTH)
        x = x + jnp.concatenate([attn, sgu], axis=-1) @ w_out[l]
        x = x + peer_ffn(rmsnorm(x, ffn_norm_w[l]), peer_wq[l], peer_keys[l], peer_u[l], peer_v[l])
    return rmsnorm(x, final_norm_w)
```

```cpp
#include <hip/hip_runtime.h>
#include <hip/hip_cooperative_groups.h>
#include <cstdio>
#include <cstdint>
namespace cg = cooperative_groups;
namespace pg8 {
#define PG8_LAS __attribute__((address_space(3)))
typedef unsigned short bf16_t;
typedef short bf16x8 __attribute__((ext_vector_type(8)));
typedef float f32x4 __attribute__((ext_vector_type(4)));
typedef unsigned u32x4 __attribute__((ext_vector_type(4)));
typedef int i32x4 __attribute__((ext_vector_type(4)));
template <bool I8> struct AccSel { typedef f32x4 T; };
template <> struct AccSel<true> { typedef i32x4 T; };
constexpr int BM = 256, BK = 64, HALF = 128, HTB = HALF * BK * 2  , STAGE_BYTES = 8 * HTB, NXCD = 8, WGM = 8;

__host__ __device__ __forceinline__ int lds_byte(int r, int c) { const int st = (r >> 4) * 2 + (c >> 5), rr = r & 15, cc = c & 31, ob = rr * 64 + cc * 2; return st * 1024 + (ob ^ (((ob >> 9) & 1) << 5)); }
__host__ __device__ __forceinline__ void stage_rc(int b, int& R, int& C) { const int st = b / 1024, sb = b % 1024, swz = sb ^ (((sb >> 9) & 1) << 5); R = (st >> 1) * 16 + swz / 64; C = (st & 1) * 32 + (swz % 64) / 2; }
__host__ __device__ __forceinline__ int perm32(int rho) { const int n = rho >> 4, i = rho & 15; return 8 * (i >> 2) + 4 * n + (i & 3); }

struct Unit { int pm, pn; };
struct Gemm { const bf16_t* A; const bf16_t* Bt; int M, N, K; };

struct StaticOrder {
    int nM, nN, nwg, G, c;
    __host__ __device__ void init(int M, int N, int G_, int c_) { nM = M / BM; nN = N / BM; nwg = nM * nN; G = G_; c = c_; }
    __host__ __device__ bool next(int i, Unit& u) const {
        const long L = (long)i * G + c; if (L >= nwg) return false;
        int wgid = (int)L; { const int q = nwg / NXCD, r = nwg % NXCD, xcd = wgid % NXCD, off = wgid / NXCD; wgid = (xcd < r ? xcd * (q + 1) : r * (q + 1) + (xcd - r) * q) + off; }
        const int nig = WGM * nN, gid = wgid / nig, fm = gid * WGM, gsz = (nM - fm) < WGM ? (nM - fm) : WGM;
        u.pm = fm + ((wgid % nig) % gsz); u.pn = (wgid % nig) / gsz; return true;
    }
    __device__ __forceinline__ void a_ready(const Unit&) const {}
    __device__ __forceinline__ void done(const Unit&) const {}
};

__device__ __forceinline__ unsigned cvt_pk_bf16(float lo, float hi) { unsigned r; asm volatile("v_cvt_pk_bf16_f32 %0, %1, %2" : "=v"(r) : "v"(lo), "v"(hi)); return r; }
typedef float f32x2 __attribute__((ext_vector_type(2)));
__device__ __forceinline__ f32x2 gelu_pk(f32x2 v) {
    const f32x2 av = __builtin_elementwise_abs(v), d = av * 0.2316418882f + 1.0f;
    f32x2 t; t.x = __builtin_amdgcn_rcpf(d.x); t.y = __builtin_amdgcn_rcpf(d.y);
    f32x2 q = t * 0.5307027145f + (-0.7265760135f); q = q * t + 0.7107068705f; q = q * t + (-0.142248368f); q = q * t + 0.127414796f; q = q * t;
    const f32x2 s = (v * v) * (-0.72134752044f);
    f32x2 e; e.x = __builtin_amdgcn_exp2f(s.x); e.y = __builtin_amdgcn_exp2f(s.y);
    const f32x2 m = v * (q * e), r = v - m;
    f32x2 o; o.x = v.x < 0.f ? m.x : r.x; o.y = v.y < 0.f ? m.y : r.y; return o;
}

template <int ACT  > struct EpiBf16 {
    static constexpr bool PERM = true, AFTER_DRAIN = false; static_assert(ACT == 0 || ACT == 1, "EpiBf16: ACT is 0 (none) or 1 (gelu_pk)");
    bf16_t* O; int ldc; const float* bias; int split_cols; size_t split_stride; float scale0;
    __device__ __forceinline__ void operator()(const f32x4 (&acc)[2][2][4][2], const Unit& u, int wr, int wc, int fr, int fq) const {
        const int row0 = u.pm * BM + wr * 64 + fr; int colt = u.pn * BM; bf16_t* base = O;
        float sc = 1.f; if (split_cols) { const int t = colt / split_cols; base += (size_t)t * split_stride; colt -= t * split_cols; if (t == 0) sc = scale0; }
        const int col0 = colt + wc * 32 + 8 * fq, bcol0 = u.pn * BM + wc * 32 + 8 * fq;
        f32x4 bv[2][2];
#pragma unroll
        for (int bj = 0; bj < 2; ++bj)
#pragma unroll
            for (int n = 0; n < 2; ++n) bv[bj][n] = bias ? *(const f32x4*)(bias + bcol0 + bj * HALF + 4 * n) : (f32x4){0.f, 0.f, 0.f, 0.f};
#pragma unroll
        for (int ai = 0; ai < 2; ++ai)
#pragma unroll
            for (int m = 0; m < 4; ++m) { bf16_t* rowp = base + (size_t)(row0 + ai * HALF + m * 16) * ldc + col0;
#pragma unroll
                for (int bj = 0; bj < 2; ++bj) { f32x4 v0 = acc[ai][bj][m][0] + bv[bj][0], v1 = acc[ai][bj][m][1] + bv[bj][1];
                    if (ACT == 1) { f32x2 a = gelu_pk((f32x2){v0[0], v0[1]}), b = gelu_pk((f32x2){v0[2], v0[3]}), c = gelu_pk((f32x2){v1[0], v1[1]}), d = gelu_pk((f32x2){v1[2], v1[3]});
                        v0 = (f32x4){a.x, a.y, b.x, b.y}; v1 = (f32x4){c.x, c.y, d.x, d.y}; }
                    v0 = v0 * sc; v1 = v1 * sc; u32x4 w; w.x = cvt_pk_bf16(v0[0], v0[1]); w.y = cvt_pk_bf16(v0[2], v0[3]); w.z = cvt_pk_bf16(v1[0], v1[1]); w.w = cvt_pk_bf16(v1[2], v1[3]);
                    *(u32x4*)(rowp + bj * HALF) = w; } }
    }
};
__device__ __forceinline__ void st_wt16(void* p, u32x4 v) { asm volatile("global_store_dwordx4 %0, %1, off sc1\n\ts_nop 2" :: "v"(p), "v"(v) : "memory"); }
__device__ __forceinline__ unsigned pk4_i8(float a, float b, float c, float d) {
    const int qa = __float2int_rn(a), qb = __float2int_rn(b), qc = __float2int_rn(c), qd = __float2int_rn(d);
    return (unsigned)(qa & 255) | ((unsigned)(qb & 255) << 8) | ((unsigned)(qc & 255) << 16) | ((unsigned)qd << 24);
}
typedef float f32x2e __attribute__((ext_vector_type(2)));
struct EpiInProj {
    static constexpr bool PERM = true, AFTER_DRAIN = false;
    bf16_t *Q, *K; const float* rope; float qscale; float* LNS; const float* SA; const float* SB;
    __device__ __forceinline__ void operator()(const i32x4 (&acc)[2][2][4][2], const Unit& u, int wr, int wc, int fr, int fq) const {
        const int row0 = u.pm * BM + wr * 64 + fr;
        const int sect = u.pn >> 1;
        float sa[2][4]; f32x4 sb[2][2];
#pragma unroll
        for (int ai = 0; ai < 2; ++ai)
#pragma unroll
            for (int m = 0; m < 4; ++m) sa[ai][m] = SA[row0 + ai * HALF + m * 16];
#pragma unroll
        for (int bj = 0; bj < 2; ++bj) { const f32x4* sp = (const f32x4*)(SB + u.pn * BM + bj * HALF + wc * 32 + 8 * fq); sb[bj][0] = sp[0]; sb[bj][1] = sp[1]; }
        f32x4 af[2][2][4][2];
#pragma unroll
        for (int ai = 0; ai < 2; ++ai)
#pragma unroll
            for (int bj = 0; bj < 2; ++bj)
#pragma unroll
                for (int m = 0; m < 4; ++m)
#pragma unroll
                    for (int n = 0; n < 2; ++n) af[ai][bj][m][n] = __builtin_convertvector(acc[ai][bj][m][n], f32x4) * sa[ai][m] * sb[bj][n];
#define DQ(ai, bj, m, n) af[ai][bj][m][n]
        const int colt = (u.pn & 1) * 256;
        if (sect <= 1) {
            const bool hiH = fq >= 2;
            bf16_t* dstb = (sect == 0) ? Q : K; const float qs = (sect == 0) ? qscale : 1.f;
#define ROPE2(oA, oB, A, B, C_, S_) { const auto r_ = __builtin_amdgcn_permlane32_swap(__float_as_uint(A), __float_as_uint(B), false, false); \
            const float x_ = __uint_as_float(r_[0]), y_ = __uint_as_float(r_[1]); const float o1_ = x_ * (C_) - y_ * (S_), o2_ = y_ * (C_) + x_ * (S_); \
            const auto q_ = __builtin_amdgcn_permlane32_swap(__float_as_uint(o1_), __float_as_uint(o2_), false, false); oA = __uint_as_float(q_[0]) * qs; oB = __uint_as_float(q_[1]) * qs; }
#pragma unroll
            for (int ai = 0; ai < 2; ++ai) {
                f32x4 cs[4][4];
#pragma unroll
                for (int m = 0; m < 4; ++m) { const int pos = (row0 + ai * HALF + m * 16) & 4095; const f32x4* rp = (const f32x4*)(rope + (size_t)pos * 32 + (fq & 1) * 16);
                    cs[m][0] = rp[0]; cs[m][1] = rp[1]; cs[m][2] = rp[2]; cs[m][3] = rp[3]; }
#pragma unroll
                for (int m = 0; m < 4; ++m) {
                    const int row = row0 + ai * HALF + m * 16;
                    float C[4], S[4];
#pragma unroll
                    for (int p = 0; p < 4; ++p) { C[p] = hiH ? cs[m][p][2] : cs[m][p][0]; S[p] = hiH ? cs[m][p][3] : cs[m][p][1]; }
#pragma unroll
                    for (int bj = 0; bj < 2; ++bj) {
                        const f32x4 va = DQ(ai, bj, m, 0), vb = DQ(ai, bj, m, 1);
                        float o[8];
                        ROPE2(o[0], o[1], va[0], va[1], C[0], S[0]) ROPE2(o[2], o[3], va[2], va[3], C[1], S[1]) ROPE2(o[4], o[5], vb[0], vb[1], C[2], S[2]) ROPE2(o[6], o[7], vb[2], vb[3], C[3], S[3])
                        const int cl = colt + bj * HALF + wc * 32;
                        u32x4 w; w.x = cvt_pk_bf16(o[0], o[1]); w.y = cvt_pk_bf16(o[2], o[3]); w.z = cvt_pk_bf16(o[4], o[5]); w.w = cvt_pk_bf16(o[6], o[7]);
                        *(u32x4*)(dstb + (size_t)row * 512 + cl + 8 * fq) = w;
                    }
                }
            }
#undef ROPE2
        } else {
            bf16_t* base = K + (size_t)(sect - 1) * ((size_t)16384 * 512);
#pragma unroll
            for (int ai = 0; ai < 2; ++ai)
#pragma unroll
                for (int m = 0; m < 4; ++m) {
                    bf16_t* rowp = base + (size_t)(row0 + ai * HALF + m * 16) * 512 + colt + wc * 32 + 8 * fq;
                    float s1 = 0.f, s2 = 0.f;
#pragma unroll
                    for (int bj = 0; bj < 2; ++bj) {
                        f32x4 v0 = DQ(ai, bj, m, 0), v1 = DQ(ai, bj, m, 1);
                        if (sect >= 3) { f32x2 a = gelu_pk((f32x2){v0[0], v0[1]}), b = gelu_pk((f32x2){v0[2], v0[3]}), c = gelu_pk((f32x2){v1[0], v1[1]}), d = gelu_pk((f32x2){v1[2], v1[3]});
                            v0 = (f32x4){a.x, a.y, b.x, b.y}; v1 = (f32x4){c.x, c.y, d.x, d.y}; }
                        u32x4 w; w.x = cvt_pk_bf16(v0[0], v0[1]); w.y = cvt_pk_bf16(v0[2], v0[3]); w.z = cvt_pk_bf16(v1[0], v1[1]); w.w = cvt_pk_bf16(v1[2], v1[3]);
                        *(u32x4*)(rowp + bj * HALF) = w;
                        if (sect == 4) { s1 += ((v0[0] + v0[1]) + (v0[2] + v0[3])) + ((v1[0] + v1[1]) + (v1[2] + v1[3]));
                            s2 += ((v0[0] * v0[0] + v0[1] * v0[1]) + (v0[2] * v0[2] + v0[3] * v0[3])) + ((v1[0] * v1[0] + v1[1] * v1[1]) + (v1[2] * v1[2] + v1[3] * v1[3])); }
                    }
                    if (sect == 4) { s1 += __shfl_xor(s1, 16); s1 += __shfl_xor(s1, 32); s2 += __shfl_xor(s2, 16); s2 += __shfl_xor(s2, 32);
                        if (fq == 0) *(f32x2e*)(LNS + ((size_t)(row0 + ai * HALF + m * 16) * 8 + (u.pn & 1) * 4 + wc) * 2) = (f32x2e){s1, s2}; }
                }
        }
#undef DQ
    }
};
struct EpiOutProj {
    static constexpr bool PERM = true, AFTER_DRAIN = false;
    const float* X; float* X1; bf16_t* X1b; float* SS; unsigned* PM; PG8_LAS float* L; unsigned char* A8; float* SA2;
    __device__ __forceinline__ void operator()(const f32x4 (&acc)[2][2][4][2], const Unit& u, int wr, int wc, int fr, int fq) const {
        const int row0 = u.pm * BM + wr * 64 + fr, col0 = u.pn * BM + wc * 32 + 8 * fq, rl0 = wr * 64 + fr;
        PG8_LAS float* LM = L; PG8_LAS float* FM = L + 1024;
        f32x4 v[2][4][2][2];
#pragma unroll
        for (int ai = 0; ai < 2; ++ai)
#pragma unroll
            for (int m = 0; m < 4; ++m) {
                const int row = row0 + ai * HALF + m * 16; float s = 0.f, am = 0.f;
#pragma unroll
                for (int bj = 0; bj < 2; ++bj) {
                    const size_t off = (size_t)row * 1024 + col0 + bj * HALF;
                    const f32x4 v0 = acc[ai][bj][m][0] + *(const f32x4*)(X + off), v1 = acc[ai][bj][m][1] + *(const f32x4*)(X + off + 4);
                    v[ai][m][bj][0] = v0; v[ai][m][bj][1] = v1;
                    s += (v0[0] * v0[0] + v0[1] * v0[1]) + (v0[2] * v0[2] + v0[3] * v0[3]) + (v1[0] * v1[0] + v1[1] * v1[1]) + (v1[2] * v1[2] + v1[3] * v1[3]);
                    am = fmaxf(am, fmaxf(fmaxf(fmaxf(fabsf(v0[0]), fabsf(v0[1])), fmaxf(fabsf(v0[2]), fabsf(v0[3]))), fmaxf(fmaxf(fabsf(v1[0]), fabsf(v1[1])), fmaxf(fabsf(v1[2]), fabsf(v1[3])))));
                }
                s += __shfl_xor(s, 16); s += __shfl_xor(s, 32); am = fmaxf(am, __shfl_xor(am, 16)); am = fmaxf(am, __shfl_xor(am, 32));
                if (fq == 0) { SS[(size_t)row * 16 + u.pn * 4 + wc] = s; LM[(rl0 + ai * HALF + m * 16) * 4 + wc] = am; }
            }
        __syncthreads();
        if (threadIdx.x < 256) {
            const int t = threadIdx.x; const f32x4 l = *(const PG8_LAS f32x4*)(LM + 4 * t);
            const float mine = fmaxf(fmaxf(l[0], l[1]), fmaxf(l[2], l[3]));
            unsigned* slot = PM + (size_t)(u.pm * BM + t) * 4;
            __hip_atomic_store(slot + u.pn, __float_as_uint(mine) | 0x80000000u, __ATOMIC_RELAXED, __HIP_MEMORY_SCOPE_AGENT);
            unsigned a0, a1, a2, a3, sp = 0;
            for (;;) { a0 = __hip_atomic_load(slot + 0, __ATOMIC_RELAXED, __HIP_MEMORY_SCOPE_AGENT); a1 = __hip_atomic_load(slot + 1, __ATOMIC_RELAXED, __HIP_MEMORY_SCOPE_AGENT);
                a2 = __hip_atomic_load(slot + 2, __ATOMIC_RELAXED, __HIP_MEMORY_SCOPE_AGENT); a3 = __hip_atomic_load(slot + 3, __ATOMIC_RELAXED, __HIP_MEMORY_SCOPE_AGENT);
                if (((a0 & a1 & a2 & a3) >> 31) != 0u || ++sp > (1u << 20)) break; __builtin_amdgcn_s_sleep(1); }
            FM[t] = fmaxf(fmaxf(__uint_as_float(a0 & 0x7fffffffu), __uint_as_float(a1 & 0x7fffffffu)), fmaxf(__uint_as_float(a2 & 0x7fffffffu), __uint_as_float(a3 & 0x7fffffffu)));
        }
        __syncthreads();
#pragma unroll
        for (int ai = 0; ai < 2; ++ai)
#pragma unroll
            for (int m = 0; m < 4; ++m) {
                const int row = row0 + ai * HALF + m * 16;
                const float am = FM[rl0 + ai * HALF + m * 16];
                const float sc = am > 0.f ? am * (1.f / 127.f) : 1.f, inv = 1.f / sc;
#pragma unroll
                for (int bj = 0; bj < 2; ++bj) { const f32x4 v0 = v[ai][m][bj][0] * inv, v1 = v[ai][m][bj][1] * inv;
                    f32x2e q; q.x = __uint_as_float(pk4_i8(v0[0], v0[1], v0[2], v0[3])); q.y = __uint_as_float(pk4_i8(v1[0], v1[1], v1[2], v1[3]));
                    *(f32x2e*)(A8 + (size_t)row * 1024 + col0 + bj * HALF) = q; }
                if (u.pn == 0 && wc == 0 && fq == 0) SA2[row] = sc;
            }
    }
};
struct EpiDq8 {
    static constexpr bool PERM = true, AFTER_DRAIN = false;
    bf16_t* O; int ldc; const float* SA; const float* SB;
    __device__ __forceinline__ void operator()(const i32x4 (&acc)[2][2][4][2], const Unit& u, int wr, int wc, int fr, int fq) const {
        const int row0 = u.pm * BM + wr * 64 + fr, col0 = u.pn * BM + wc * 32 + 8 * fq;
        f32x4 sb[2][2];
#pragma unroll
        for (int bj = 0; bj < 2; ++bj) { const f32x4* sp = (const f32x4*)(SB + col0 + bj * HALF); sb[bj][0] = sp[0]; sb[bj][1] = sp[1]; }
#pragma unroll
        for (int ai = 0; ai < 2; ++ai)
#pragma unroll
            for (int m = 0; m < 4; ++m) { const int row = row0 + ai * HALF + m * 16; const float sa = SA[row];
#pragma unroll
                for (int bj = 0; bj < 2; ++bj) { const f32x4 v0 = __builtin_convertvector(acc[ai][bj][m][0], f32x4) * sa * sb[bj][0], v1 = __builtin_convertvector(acc[ai][bj][m][1], f32x4) * sa * sb[bj][1];
                    u32x4 w; w.x = cvt_pk_bf16(v0[0], v0[1]); w.y = cvt_pk_bf16(v0[2], v0[3]); w.z = cvt_pk_bf16(v1[0], v1[1]); w.w = cvt_pk_bf16(v1[2], v1[3]);
                    st_wt16(O + (size_t)row * ldc + col0 + bj * HALF, w); } }
    }
};

template <class Epi, class Sched, bool ALIGN_EPI = false, bool SP2 = false, bool I8 = false>
__device__ __forceinline__ void gemm_phase(PG8_LAS unsigned char* lds, const Gemm g, const Sched& S, const Epi& E) {
    int tid_ = threadIdx.x; asm volatile("" : "+v"(tid_));
    const int tid = tid_, wid = __builtin_amdgcn_readfirstlane(tid >> 6), lane = tid & 63, wr = wid >> 2, wc = wid & 3, fr = lane & 15, fq = lane >> 4;
    const int K = g.K, nt = K / BK;
    unsigned voffA[2], voffB[2];
#pragma unroll
    for (int i = 0; i < 2; ++i) { int R, C; stage_rc(tid * 16 + i * 8192, R, C); const int Rb = Epi::PERM ? ((R & ~31) + perm32(R & 31)) : R;
        voffA[i] = (unsigned)(R * K + C) * 2u; voffB[i] = (unsigned)(Rb * K + C) * 2u; }
    const size_t kstep = (size_t)(BK * 2);
    const size_t hstep = (size_t)HALF * K * 2;
    const size_t tstep = 2 * hstep;
    const unsigned ldsw = (unsigned)wid * 1024u;
    const int aoff = lds_byte(wr * 64 + fr, fq * 8), boff = lds_byte(wc * 32 + fr, fq * 8);
#define PG8_SA(b, h) (((b) * 2 + (h)) * HTB)
#define PG8_SB(b, h) ((4 + (b) * 2 + (h)) * HTB)
#define PG8_STAGE(bufoff, gbase, voff) do { _Pragma("unroll") for (int _i = 0; _i < 2; ++_i) \
        __builtin_amdgcn_global_load_lds((const unsigned*)((const char*)(gbase) + (voff)[_i]), (PG8_LAS unsigned*)(lds + (bufoff) + ldsw + _i * 8192), 16, 0, 0); } while (0)
#define PG8_LDA(dst, b, h) do { _Pragma("unroll") for (int m = 0; m < 4; ++m) _Pragma("unroll") for (int k = 0; k < 2; ++k) dst[m][k] = *(const PG8_LAS bf16x8*)(lds + PG8_SA(b, h) + aoff + m * 2048 + k * 1024); } while (0)
#define PG8_LDB(dst, b, h) do { _Pragma("unroll") for (int n = 0; n < 2; ++n) _Pragma("unroll") for (int k = 0; k < 2; ++k) dst[n][k] = *(const PG8_LAS bf16x8*)(lds + PG8_SB(b, h) + boff + n * 2048 + k * 1024); } while (0)
#define PG8_MMA(ai, bj, At, Bt) do { __builtin_amdgcn_s_setprio(1); _Pragma("unroll") for (int m = 0; m < 4; ++m) _Pragma("unroll") for (int n = 0; n < 2; ++n) _Pragma("unroll") for (int k = 0; k < 2; ++k) \
        { if constexpr (I8) acc[ai][bj][m][n] = __builtin_bit_cast(AccT, __builtin_amdgcn_mfma_i32_16x16x64_i8(__builtin_bit_cast(i32x4, Bt[n][k]), __builtin_bit_cast(i32x4, At[m][k]), __builtin_bit_cast(i32x4, acc[ai][bj][m][n]), 0, 0, 0)); \
          else acc[ai][bj][m][n] = __builtin_bit_cast(AccT, __builtin_amdgcn_mfma_f32_16x16x32_bf16(Bt[n][k], At[m][k], __builtin_bit_cast(f32x4, acc[ai][bj][m][n]), 0, 0, 0)); } __builtin_amdgcn_s_setprio(0); } while (0)
#define PG8_WAIT_V(n) asm volatile("s_waitcnt vmcnt(" #n ")" ::: "memory")
#define PG8_WAIT_L(n) asm volatile("s_waitcnt lgkmcnt(" #n ")" ::: "memory")
#define PG8_BAR __builtin_amdgcn_s_barrier()
#define PG8_SCHED __builtin_amdgcn_sched_barrier(0)
    Unit cur, nxt; int ui = 0;
    if (!S.next(0, cur)) return;
    typedef typename AccSel<I8>::T AccT;
    AccT acc[2][2][4][2];
#pragma unroll
    for (int a = 0; a < 2; ++a)
#pragma unroll
        for (int b = 0; b < 2; ++b)
#pragma unroll
            for (int m = 0; m < 4; ++m)
#pragma unroll
                for (int n = 0; n < 2; ++n) acc[a][b][m][n] = (AccT){0, 0, 0, 0};
    bf16x8 At[4][2], B0[2][2], B1[2][2];
    const char* cA = (const char*)g.A + (size_t)cur.pm * tstep; const char* cB = (const char*)g.Bt + (size_t)cur.pn * tstep;
    S.a_ready(cur);
    if constexpr (SP2) {
        PG8_STAGE(PG8_SB(0, 0), cB, voffB); PG8_STAGE(PG8_SB(0, 1), cB + hstep, voffB); PG8_STAGE(PG8_SA(0, 0), cA, voffA); PG8_STAGE(PG8_SA(0, 1), cA + hstep, voffA);
        if (wr == 1) PG8_BAR;
        PG8_WAIT_V(2); PG8_BAR;
        PG8_STAGE(PG8_SB(1, 0), cB + kstep, voffB); PG8_STAGE(PG8_SA(1, 0), cA + kstep, voffA); PG8_STAGE(PG8_SB(1, 1), cB + hstep + kstep, voffB);
        PG8_WAIT_V(6); PG8_BAR;
    } else {
        PG8_STAGE(PG8_SB(0, 0), cB, voffB); PG8_STAGE(PG8_SA(0, 0), cA, voffA); PG8_STAGE(PG8_SB(0, 1), cB + hstep, voffB); PG8_STAGE(PG8_SA(0, 1), cA + hstep, voffA);
        if (wr == 1) PG8_BAR;
        PG8_WAIT_V(4); PG8_BAR;
        PG8_STAGE(PG8_SB(1, 0), cB + kstep, voffB); PG8_STAGE(PG8_SA(1, 0), cA + kstep, voffA); PG8_STAGE(PG8_SB(1, 1), cB + hstep + kstep, voffB);
        PG8_WAIT_V(6); PG8_BAR;
    }
    for (;;) {
        const bool has_next = S.next(ui + 1, nxt);
        const char* nA = has_next ? (const char*)g.A + (size_t)nxt.pm * tstep : cA; const char* nB = has_next ? (const char*)g.Bt + (size_t)nxt.pn * tstep : cB;
        for (int t = 0; t < nt; t += 2) {
            const bool last = (t == nt - 2);
            const char* a1 = cA + (size_t)(t + 1) * kstep;
            const char* a2 = last ? nA : cA + (size_t)(t + 2) * kstep; const char* b2 = last ? nB : cB + (size_t)(t + 2) * kstep;
            const char* a3 = a2 + kstep; const char* b3 = b2 + kstep;
            if (last && has_next) S.a_ready(nxt);
            if constexpr (SP2) {
            PG8_LDB(B0, 0, 0); PG8_LDB(B1, 0, 1); PG8_SCHED; PG8_LDA(At, 0, 0); PG8_STAGE(PG8_SA(1, 1), a1 + hstep, voffA);
            PG8_WAIT_V(8); PG8_WAIT_L(0); PG8_BAR; PG8_MMA(0, 0, At, B0); PG8_MMA(0, 1, At, B1); PG8_BAR; PG8_SCHED;
            PG8_LDA(At, 0, 1); PG8_STAGE(PG8_SB(0, 0), b2, voffB); PG8_STAGE(PG8_SB(0, 1), b2 + hstep, voffB); PG8_STAGE(PG8_SA(0, 0), a2, voffA);
            PG8_WAIT_V(8); PG8_WAIT_L(0); PG8_BAR; PG8_MMA(1, 0, At, B0); PG8_MMA(1, 1, At, B1); PG8_BAR; PG8_SCHED;
            PG8_LDB(B0, 1, 0); PG8_LDB(B1, 1, 1); PG8_SCHED; PG8_LDA(At, 1, 0); PG8_STAGE(PG8_SA(0, 1), a2 + hstep, voffA);
            PG8_WAIT_V(8); PG8_WAIT_L(0); PG8_BAR; PG8_MMA(0, 0, At, B0); PG8_MMA(0, 1, At, B1); PG8_BAR; PG8_SCHED;
            PG8_LDA(At, 1, 1); PG8_STAGE(PG8_SB(1, 0), b3, voffB); PG8_STAGE(PG8_SB(1, 1), b3 + hstep, voffB); PG8_STAGE(PG8_SA(1, 0), a3, voffA);
            PG8_WAIT_V(8); PG8_WAIT_L(0); PG8_BAR; PG8_MMA(1, 0, At, B0); PG8_MMA(1, 1, At, B1); PG8_BAR; PG8_SCHED;
            } else {
            PG8_LDB(B0, 0, 0); PG8_SCHED; PG8_LDA(At, 0, 0); PG8_STAGE(PG8_SA(1, 1), a1 + hstep, voffA);
            PG8_WAIT_L(8); PG8_BAR; PG8_WAIT_L(0); PG8_MMA(0, 0, At, B0); PG8_BAR; PG8_SCHED;
            PG8_LDB(B1, 0, 1); PG8_STAGE(PG8_SB(0, 0), b2, voffB);
            PG8_BAR; PG8_WAIT_L(0); PG8_MMA(0, 1, At, B1); PG8_BAR;
            PG8_LDA(At, 0, 1); PG8_STAGE(PG8_SA(0, 0), a2, voffA);
            PG8_BAR; PG8_WAIT_L(0); PG8_MMA(1, 0, At, B0); PG8_BAR; PG8_SCHED;
            PG8_STAGE(PG8_SB(0, 1), b2 + hstep, voffB);
            PG8_WAIT_V(6); PG8_BAR; PG8_MMA(1, 1, At, B1); PG8_BAR;
            PG8_LDB(B0, 1, 0); PG8_SCHED; PG8_LDA(At, 1, 0); PG8_STAGE(PG8_SA(0, 1), a2 + hstep, voffA);
            PG8_WAIT_L(8); PG8_BAR; PG8_WAIT_L(0); PG8_MMA(0, 0, At, B0); PG8_BAR; PG8_SCHED;
            PG8_LDB(B1, 1, 1); PG8_STAGE(PG8_SB(1, 0), b3, voffB);
            PG8_BAR; PG8_WAIT_L(0); PG8_MMA(0, 1, At, B1); PG8_BAR;
            PG8_LDA(At, 1, 1); PG8_STAGE(PG8_SA(1, 0), a3, voffA);
            PG8_BAR; PG8_WAIT_L(0); PG8_MMA(1, 0, At, B0); PG8_BAR; PG8_SCHED;
            PG8_STAGE(PG8_SB(1, 1), b3 + hstep, voffB);
            PG8_WAIT_V(6); PG8_BAR; PG8_MMA(1, 1, At, B1); PG8_BAR;
            }
        }
        if constexpr (ALIGN_EPI) { if (wr == 0) PG8_BAR; }
        if constexpr (!Epi::AFTER_DRAIN) { E(acc, cur, wr, wc, fr, fq); S.done(cur); }
        if (!has_next) break;
#pragma unroll
        for (int a = 0; a < 2; ++a)
#pragma unroll
            for (int b = 0; b < 2; ++b)
#pragma unroll
                for (int m = 0; m < 4; ++m)
#pragma unroll
                    for (int n = 0; n < 2; ++n) acc[a][b][m][n] = (AccT){0, 0, 0, 0};
        cur = nxt; cA = nA; cB = nB; ++ui;
        if constexpr (ALIGN_EPI) { if (wr == 1) PG8_BAR; }
    }
    PG8_WAIT_V(0);
    if constexpr (!ALIGN_EPI) { if (wr == 0) PG8_BAR; }
    PG8_BAR;
    if constexpr (Epi::AFTER_DRAIN) { E.fused(acc, cur, wr, wc, fr, fq, lds, wid, lane); S.done(cur); }
#undef PG8_SA
#undef PG8_SB
#undef PG8_STAGE
#undef PG8_LDA
#undef PG8_LDB
#undef PG8_MMA
#undef PG8_WAIT_V
#undef PG8_WAIT_L
#undef PG8_BAR
#undef PG8_SCHED
}
}
#include <hip/hip_bf16.h>
#include <cmath>
namespace attn_body {
using bf16=__hip_bfloat16;
using bf16x8=__attribute__((ext_vector_type(8)))short;
using s16x4=__attribute__((ext_vector_type(4)))short;
using f32x16=__attribute__((ext_vector_type(16)))float;
using u32x4=__attribute__((ext_vector_type(4)))unsigned;
constexpr int BATCH=4,NHEAD=16,SEQ=4096,D=64,DM=NHEAD*D,KVP=512;
constexpr int NW=8,QBLK=32,QB=QBLK*NW,KVBLK=64,NQB=SEQ/QB;
constexpr int ATTN_PITCH=DM, ATTN_UNIT_ROWS=QB;
__device__ __forceinline__ int crow(int r,int hi){return (r&3)+8*(r>>2)+4*hi;}
#define SBAR() __builtin_amdgcn_sched_barrier(0)
__device__ __forceinline__ void cmask(f32x16&p0,f32x16&p1,int jb,int qrel,int hi){
  const float NEG=-INFINITY; int kb=64*jb+4*hi;
  #pragma unroll
  for(int r=0;r<16;++r){int kv=kb+(r&3)+8*(r>>2); if(kv>qrel)p0[r]=NEG; if(kv+32>qrel)p1[r]=NEG;}
}

constexpr int NSLOT=3, SLOTB=8192;
constexpr int LDS_K=0, LDS_V=NSLOT*SLOTB, LDS_WS=2*NSLOT*SLOTB, LDS_OST=LDS_WS+NW*64*4, LDS_SAV=LDS_OST+NW*4096, LDS_BYTES=LDS_SAV+NW*4096;
constexpr float C2=0.17677669529663687f*1.4426950408889634f;
__device__ __forceinline__ void glds16(const void*gsrc,unsigned lds_dst){unsigned keep;
  asm volatile("s_mov_b32 %0, m0\n\ts_mov_b32 m0, %2\n\ts_nop 0\n\tglobal_load_lds_dwordx4 %1, off\n\ts_mov_b32 m0, %0":"=&s"(keep):"v"(gsrc),"s"(lds_dst):"memory");}
__device__ __forceinline__ float max3f(float a,float b,float c){float r;asm("v_max3_f32 %0, %1, %2, %3":"=v"(r):"v"(a),"v"(b),"v"(c));return r;}
__device__ __forceinline__ float max2f(float a,float b){float r;asm("v_max_f32_e32 %0, %1, %2":"=v"(r):"v"(a),"v"(b));return r;}
__device__ __forceinline__ float fadd_s(float a,float b){float r;asm("v_add_f32_e32 %0, %1, %2":"=v"(r):"v"(a),"v"(b));return r;}
__device__ __forceinline__ float fsub_s(float a,float b){float r;asm("v_sub_f32_e32 %0, %1, %2":"=v"(r):"v"(a),"v"(b));return r;}
typedef float f32x2_t __attribute__((ext_vector_type(2))); typedef __bf16 bf16x2_t __attribute__((ext_vector_type(2)));
__device__ __forceinline__ unsigned cvtpk_s(float lo,float hi){f32x2_t v={lo,hi};bf16x2_t b=__builtin_convertvector(v,bf16x2_t);return __builtin_bit_cast(unsigned,b);}
#define WAIT_BAR(N) asm volatile("s_waitcnt vmcnt(" #N ") lgkmcnt(0)\n\ts_barrier":::"memory")

template<int PASS> __device__ __forceinline__ void qkt(f32x16&p0,f32x16&p1,const char*Kslot,const bf16x8*qr,const f32x16&negm,int r32,int hi){
  const char*kb=Kslot+hi*1024+r32*16+PASS*4096;
  #pragma unroll
  for(int d0=0;d0<2;++d0){
    const bf16x8 b0=*reinterpret_cast<const bf16x8*>(kb+d0*2048);
    const bf16x8 b1=*reinterpret_cast<const bf16x8*>(kb+d0*2048+512);
    if(d0==0){p0=__builtin_amdgcn_mfma_f32_32x32x16_bf16(b0,qr[0],negm,0,0,0);p1=__builtin_amdgcn_mfma_f32_32x32x16_bf16(b1,qr[0],negm,0,0,0);}
    else{p0=__builtin_amdgcn_mfma_f32_32x32x16_bf16(b0,qr[d0],p0,0,0,0);p1=__builtin_amdgcn_mfma_f32_32x32x16_bf16(b1,qr[d0],p1,0,0,0);}}
}
typedef __attribute__((address_space(3))) const char* lds_cptr;
typedef short v4i16_t __attribute__((ext_vector_type(4)));
__device__ __forceinline__ void kload8(bf16x8*kf,lds_cptr kp){
  kf[0]=*(const __attribute__((address_space(3))) bf16x8*)(kp);      kf[1]=*(const __attribute__((address_space(3))) bf16x8*)(kp+512);
  kf[2]=*(const __attribute__((address_space(3))) bf16x8*)(kp+2048); kf[3]=*(const __attribute__((address_space(3))) bf16x8*)(kp+2560);
}
__device__ __forceinline__ void kload2(bf16x8*kf,lds_cptr kp,int j){ kf[2*j]=*(const __attribute__((address_space(3))) bf16x8*)(kp+j*2048); kf[2*j+1]=*(const __attribute__((address_space(3))) bf16x8*)(kp+j*2048+512); }
__device__ __forceinline__ s16x4 vtr(lds_cptr p){ return __builtin_bit_cast(s16x4,__builtin_amdgcn_ds_read_tr16_b64_v4i16((__attribute__((address_space(3))) v4i16_t*)p)); }
__device__ __forceinline__ float rowmax(const f32x16&p0,const f32x16&p1){
  float a=max3f(p0[0],p0[1],p1[0]),b=max3f(p0[2],p0[3],p1[1]);a=max3f(a,p1[2],p1[3]);
  #pragma unroll
  for(int r=4;r<16;r+=4){a=max3f(a,p0[r],p0[r+1]);b=max3f(b,p0[r+2],p0[r+3]);a=max3f(a,p1[r],p1[r+1]);b=max3f(b,p1[r+2],p1[r+3]);}
  const float m=max2f(a,b);
  auto rr=__builtin_amdgcn_permlane32_swap(__float_as_uint(m),__float_as_uint(m),false,false);
  return max2f(__uint_as_float(rr[0]),__uint_as_float(rr[1]));
}
__device__ __forceinline__ void pv(f32x16*o,int vb,bf16x8 pa0,bf16x8 pa1,bf16x8 pa2,bf16x8 pa3){
  #pragma unroll
  for(int d0=0;d0<2;++d0){s16x4 lo[4],hi[4];
    #pragma unroll
    for(int ks=0;ks<4;++ks){
      asm volatile("ds_read_b64_tr_b16 %0,%1 offset:%c2":"=&v"(lo[ks]):"v"(vb),"i"(d0*4096+ks*1024):"memory");
      asm volatile("ds_read_b64_tr_b16 %0,%1 offset:%c2":"=&v"(hi[ks]):"v"(vb),"i"(d0*4096+ks*1024+512):"memory");}
    asm volatile("s_waitcnt lgkmcnt(0)":::"memory");SBAR();
    #define PK(k) (bf16x8){lo[k][0],lo[k][1],lo[k][2],lo[k][3],hi[k][0],hi[k][1],hi[k][2],hi[k][3]}
    o[d0]=__builtin_amdgcn_mfma_f32_32x32x16_bf16(pa0,PK(0),o[d0],0,0,0);
    o[d0]=__builtin_amdgcn_mfma_f32_32x32x16_bf16(pa1,PK(1),o[d0],0,0,0);
    o[d0]=__builtin_amdgcn_mfma_f32_32x32x16_bf16(pa2,PK(2),o[d0],0,0,0);
    o[d0]=__builtin_amdgcn_mfma_f32_32x32x16_bf16(pa3,PK(3),o[d0],0,0,0);
    #undef PK
  }
}

#ifndef ATTN_STORE16
#define ATTN_STORE16(p,v) (*(u32x4*)(p)=(v))
#endif
template<int THRL,int PASS> __device__ __forceinline__ void attn_unit(int b,int h,int qb,const bf16*Q,const bf16*__restrict__ K,const bf16*__restrict__ V,bf16*O,char*shm,float lam,const float*subw){
  int tid_=threadIdx.x; asm volatile("":"+v"(tid_)); const int tid=tid_,lane=tid&63,r32=lane&31,hi=lane>>5; const int wid=__builtin_amdgcn_readfirstlane(tid>>6);
  const long rowbase=(long)b*SEQ; const int q0=qb*QB;
  constexpr int pass=PASS; const bf16*Qw=Q+(rowbase+q0+wid*QBLK)*KVP+h*D+PASS*32;
  const bf16*Kh=K+rowbase*KVP+h*D,*Vh=V+rowbase*KVP+h*D;
  const unsigned lds0=(unsigned)(uintptr_t)shm;
  float*wsf=(float*)(shm+LDS_WS)+wid*64;
  const bf16*ksrc=Kh+(long)lane*KVP+wid*8;
  const bf16*vsrc=Vh+(long)(16*(wid&3)+(lane>>2))*KVP+(wid>>2)*32+(lane&3)*8;
  const unsigned kdst=lds0+LDS_K+wid*1024, vdst=lds0+LDS_V+wid*1024;
  #define DMA_K(t,slot) glds16(ksrc+(long)(t)*KVBLK*KVP,(unsigned)__builtin_amdgcn_readfirstlane(kdst+(slot)))
  #define DMA_V(t,slot) glds16(vsrc+(long)(t)*KVBLK*KVP,(unsigned)__builtin_amdgcn_readfirstlane(vdst+(slot)))
  const int vb0=(int)(lds0+LDS_V)+((lane>>4)&1)*32+(lane&3)*8+(4*hi+((lane&15)>>2))*64;
  const char*Kbase=shm+LDS_K; bf16x8 kf[4];
  const lds_cptr shm3=(lds_cptr)shm; const lds_cptr kp0=shm3+LDS_K+hi*1024+r32*16+PASS*4096; const lds_cptr vp0=shm3+LDS_V+((lane>>4)&1)*32+(lane&3)*8+(4*hi+((lane&15)>>2))*64;
  const int NT=(q0+QB)/KVBLK;
  DMA_K(0,0);DMA_V(0,0);DMA_K(1,SLOTB);
  bf16x8 qr[2];
  #pragma unroll
  for(int d0=0;d0<2;++d0)qr[d0]=*reinterpret_cast<const bf16x8*>(&Qw[(long)r32*KVP+d0*16+hi*8]);
  float mhat=0.f,l_reg=0.f;f32x16 o[2];o[0]=f32x16{};o[1]=f32x16{};f32x16 negm=f32x16{};asm volatile("":"+v"(negm));
  const int qrel=wid*QBLK+r32;
  #define CMASK(P0,P1,t) do{int jb_=(t)-(NT-4); if(jb_>=0)cmask(P0,P1,jb_,qrel,hi);}while(0)
  bool resc=false;
  #define START(P0,P1) do{ const float rm=rowmax(P0,P1); resc=false; \
    { const float dl=rm; mhat=fadd_s(mhat,dl); \
      _Pragma("unroll") for(int r=0;r<16;++r){P0[r]=fsub_s(P0[r],dl);P1[r]=fsub_s(P1[r],dl);} \
      _Pragma("unroll") for(int r=0;r<16;++r)negm[r]=-mhat; asm volatile("":"+v"(negm)); } \
    _Pragma("unroll") for(int r=0;r<16;++r)P0[r]=__builtin_amdgcn_exp2f(P0[r]); }while(0)
  #define RESC() do{ if(resc){ asm volatile("s_waitcnt lgkmcnt(0)":::"memory"); \
      _Pragma("unroll") for(int d_=0;d_<2;++d_) _Pragma("unroll") for(int r=0;r<16;++r)o[d_][r]*=wsf[crow(r,hi)]; } }while(0)
  f32x16 pA0,pA1,pB0,pB1;
  int sl_prev=0,sl_cur=0,sl_next=SLOTB;
  #define ROT() do{sl_prev=sl_cur;sl_cur=sl_next;sl_next=(sl_next==(NSLOT-1)*SLOTB)?0:sl_next+SLOTB;}while(0)
  DMA_K(2,2*SLOTB);
  WAIT_BAR(3);
  qkt<PASS>(pA0,pA1,Kbase,qr,negm,r32,hi);asm volatile("s_nop 15\n\ts_nop 7":"+v"(pA0),"+v"(pA1));CMASK(pA0,pA1,0);
  START(pA0,pA1);
  _Pragma("unroll") for(int r=0;r<16;++r)pA1[r]=__builtin_amdgcn_exp2f(pA1[r]);
  WAIT_BAR(0);
  DMA_K(3,0);DMA_V(1,SLOTB);
  ROT();
  kload8(kf,kp0+sl_cur);
  WAIT_BAR(2);
  s16x4 vlo[8],vhi[8]; u32x4 pw0,pw1,pw2,pw3;
  #define PKW(P,B) cvtpk_s(P[B],P[B+1])
  #define PAF(k) __builtin_bit_cast(bf16x8,pw##k)
  #define VFR(i) (bf16x8){vlo[i][0],vlo[i][1],vlo[i][2],vlo[i][3],vhi[i][0],vhi[i][1],vhi[i][2],vhi[i][3]}
  #define PIN(x) asm volatile("":"+v"(x))
  #define MX3(a,b,c) __builtin_fmaxf(__builtin_fmaxf((a),(b)),(c))
  #define GAPA(MF,A0,A1,A2,A3,W0,W1,PW) do{ MF; sacc+=A0; sacc+=A1; sacc+=A2; sacc+=A3; PIN(sacc); W0; W1; PIN(PW); SBAR(); }while(0)
  #define EX(v) __builtin_amdgcn_exp2f(v)
  #define GAPB(MF,X,B) do{ MF; X[B]=EX(X[B]); X[B+1]=EX(X[B+1]); X[B+2]=EX(X[B+2]); X[B+3]=EX(X[B+3]); PIN(X); SBAR(); }while(0)
  #define VRD(i) do{ vlo[i]=vtr(vp_+(((i)>>2)*4096+((i)&3)*1024)); vhi[i]=vtr(vp_+(((i)>>2)*4096+((i)&3)*1024+512)); }while(0)
  #define KRD(G,j) do{ if(G){ kload2(kf,kp0+sl_next,j); SBAR(); } }while(0)
  #define STEP(C0,C1,P0,P1,t,GK,GV,GL) do{ SBAR(); \
    const lds_cptr vp_=vp0+sl_prev; \
    VRD(0); SBAR(); float sacc=(P0[0]+P0[1]); \
    GAPA(C0=__builtin_amdgcn_mfma_f32_32x32x16_bf16(kf[0],qr[0],negm,0,0,0), P0[2],P0[3],P0[4],P0[5],     pw0[0]=PKW(P0,0), pw0[1]=PKW(P0,2), pw0); \
    VRD(4); SBAR(); GAPA(C1=__builtin_amdgcn_mfma_f32_32x32x16_bf16(kf[1],qr[0],negm,0,0,0), P0[6],P0[7],P0[8],P0[9],     pw0[2]=PKW(P0,4), pw0[3]=PKW(P0,6), pw0); \
    VRD(1); SBAR(); GAPA(C0=__builtin_amdgcn_mfma_f32_32x32x16_bf16(kf[2],qr[1],C0,0,0,0),   P0[10],P0[11],P0[12],P0[13], pw1[0]=PKW(P0,8), pw1[1]=PKW(P0,10), pw1); \
    VRD(5); SBAR(); GAPA(C1=__builtin_amdgcn_mfma_f32_32x32x16_bf16(kf[3],qr[1],C1,0,0,0),   P0[14],P0[15],P1[0],P1[1],   pw1[2]=PKW(P0,12),pw1[3]=PKW(P0,14), pw1); \
    VRD(2); SBAR(); GAPA((void)0,   P1[2],P1[3],P1[4],P1[5],     pw2[0]=PKW(P1,0), pw2[1]=PKW(P1,2), pw2); \
    VRD(6); SBAR(); GAPA((void)0,   P1[6],P1[7],P1[8],P1[9],     pw2[2]=PKW(P1,4), pw2[3]=PKW(P1,6), pw2); \
    VRD(3); SBAR(); GAPA((void)0,   P1[10],P1[11],P1[12],P1[13], pw3[0]=PKW(P1,8), pw3[1]=PKW(P1,10), pw3); \
    VRD(7); SBAR(); GAPA((void)0,   P1[14],P1[15],0.f,0.f,       pw3[2]=PKW(P1,12),pw3[3]=PKW(P1,14), pw3); \
    l_reg+=sacc; \
    if(GK){DMA_K((t)+3,sl_cur);} if(GV){DMA_V((t)+1,sl_next);} \
    CMASK(C0,C1,t); \
    { float a=MX3(C0[0],C0[1],C1[0]),b=MX3(C0[2],C0[3],C1[1]); a=MX3(a,C1[2],C1[3]); \
      _Pragma("unroll") for(int r=4;r<16;r+=4){a=MX3(a,C0[r],C0[r+1]);b=MX3(b,C0[r+2],C0[r+3]);a=MX3(a,C1[r],C1[r+1]);b=MX3(b,C1[r+2],C1[r+3]);} \
      float rm=__builtin_fmaxf(a,b); { auto rr=__builtin_amdgcn_permlane32_swap(__float_as_uint(rm),__float_as_uint(rm),false,false); rm=__builtin_fmaxf(__uint_as_float(rr[0]),__uint_as_float(rr[1])); } \
      resc=false; \
      if(__builtin_expect(__any(rm>(float)THRL),0)){ const float dl=__builtin_fmaxf(rm,0.f); mhat+=dl; \
        _Pragma("unroll") for(int r=0;r<16;++r){C0[r]-=dl;C1[r]-=dl;} \
        _Pragma("unroll") for(int r=0;r<16;++r)negm[r]=-mhat; asm volatile("":"+v"(negm)); \
        const float f=__builtin_amdgcn_exp2f(-dl); l_reg*=f; if(hi==0)wsf[r32]=f; resc=true; } } \
    SBAR(); \
    GAPB(o[0]=__builtin_amdgcn_mfma_f32_32x32x16_bf16(PAF(0),VFR(0),o[0],0,0,0), C0,0); \
    GAPB(o[1]=__builtin_amdgcn_mfma_f32_32x32x16_bf16(PAF(0),VFR(4),o[1],0,0,0), C0,4); \
    KRD(GL,0); GAPB(o[0]=__builtin_amdgcn_mfma_f32_32x32x16_bf16(PAF(1),VFR(1),o[0],0,0,0), C0,8); \
    KRD(GL,1); GAPB(o[1]=__builtin_amdgcn_mfma_f32_32x32x16_bf16(PAF(1),VFR(5),o[1],0,0,0), C0,12); \
    GAPB(o[0]=__builtin_amdgcn_mfma_f32_32x32x16_bf16(PAF(2),VFR(2),o[0],0,0,0), C1,0); \
    GAPB(o[1]=__builtin_amdgcn_mfma_f32_32x32x16_bf16(PAF(2),VFR(6),o[1],0,0,0), C1,4); \
    GAPB(o[0]=__builtin_amdgcn_mfma_f32_32x32x16_bf16(PAF(3),VFR(3),o[0],0,0,0), C1,8); \
    GAPB(o[1]=__builtin_amdgcn_mfma_f32_32x32x16_bf16(PAF(3),VFR(7),o[1],0,0,0), C1,12); \
    }while(0)
  int t=1;
  #undef CMASK
  #define CMASK(P0,P1,t) do{}while(0)
  for(;t+5<NT;t+=2){
    STEP(pB0,pB1,pA0,pA1,t,true,true,true);     WAIT_BAR(2); RESC(); ROT();
    STEP(pA0,pA1,pB0,pB1,t+1,true,true,true);   WAIT_BAR(2); RESC(); ROT();
  }
  #undef CMASK
  #define CMASK(P0,P1,t) do{int jb_=(t)-(NT-4); if(jb_>=0)cmask(P0,P1,jb_,qrel,hi);}while(0)
  #define ENDW(tt) do{ if((tt)+3<NT){WAIT_BAR(2);} else if((tt)+2<NT){WAIT_BAR(1);} else {WAIT_BAR(0);} }while(0)
  for(;t+1<NT;t+=2){
    STEP(pB0,pB1,pA0,pA1,t,(t+3<NT),(t+1<NT),(t+1<NT));       ENDW(t);   RESC(); ROT();
    STEP(pA0,pA1,pB0,pB1,t+1,(t+4<NT),(t+2<NT),(t+2<NT));     ENDW(t+1); RESC(); ROT();
  }
  STEP(pB0,pB1,pA0,pA1,NT-1,false,false,false); RESC();
  { float sacc=pB0[0]+pB0[1]; _Pragma("unroll") for(int r=2;r<16;++r)sacc+=pB0[r]; _Pragma("unroll") for(int r=0;r<16;++r)sacc+=pB1[r]; l_reg+=sacc;
    pw0=(u32x4){PKW(pB0,0),PKW(pB0,2),PKW(pB0,4),PKW(pB0,6)};pw1=(u32x4){PKW(pB0,8),PKW(pB0,10),PKW(pB0,12),PKW(pB0,14)};pw2=(u32x4){PKW(pB1,0),PKW(pB1,2),PKW(pB1,4),PKW(pB1,6)};pw3=(u32x4){PKW(pB1,8),PKW(pB1,10),PKW(pB1,12),PKW(pB1,14)};
    SBAR(); pv(o,vb0+sl_cur,PAF(0),PAF(1),PAF(2),PAF(3)); }
  #undef PKW
  #undef PAF
  #undef VFR
  #undef PIN
  #undef MX3
  #undef GAPA
  #undef GAPB
  #undef EX
  #undef VRD
  #undef KRD
  #undef STEP
  #undef ENDW
  {auto rr=__builtin_amdgcn_permlane32_swap(__float_as_uint(l_reg),__float_as_uint(l_reg),false,false);l_reg=__uint_as_float(rr[0])+__uint_as_float(rr[1]);}
  if(hi==0)wsf[32+r32]=l_reg;asm volatile("s_waitcnt lgkmcnt(0)":::"memory");
  float rli[16];
  #pragma unroll
  for(int r=0;r<16;++r)rli[r]=__builtin_amdgcn_rcpf(wsf[32+crow(r,hi)]);
  bf16*Ow=O+(rowbase+q0+wid*QBLK)*DM+h*D;
  { bf16*stg=(bf16*)(shm+(pass==0?LDS_SAV:LDS_OST))+wid*2048;
    #pragma unroll
    for(int r=0;r<16;++r){const int orow=crow(r,hi);
      #pragma unroll
      for(int d0=0;d0<2;++d0)stg[orow*64+d0*32+r32]=__float2bfloat16(o[d0][r]*rli[r]);}
    asm volatile("s_waitcnt lgkmcnt(0)":::"memory");
    if(pass==1){ const bf16*sav=(const bf16*)(shm+LDS_SAV)+wid*2048; const int ch=lane&7;
      float sw[8]; const float*sp=subw+ch*8; asm volatile("":"+v"(sp));
      #pragma unroll
      for(int e=0;e<8;++e)sw[e]=sp[e]*0.8f;
      #pragma unroll
      for(int i=0;i<4;++i){const int row=i*8+(lane>>3); const u32x4 v2=*(const u32x4*)(stg+row*64+ch*8); const u32x4 v1=*(const u32x4*)(sav+row*64+ch*8);
        float dd[8]; float ss=0.f;
        #pragma unroll
        for(int e=0;e<4;++e){ const unsigned a=v1[e],c=v2[e];
          const float a0=__uint_as_float(a<<16),a1=__uint_as_float(a&0xffff0000u),c0=__uint_as_float(c<<16),c1=__uint_as_float(c&0xffff0000u);
          dd[2*e]=a0-lam*c0; dd[2*e+1]=a1-lam*c1; ss+=dd[2*e]*dd[2*e]+dd[2*e+1]*dd[2*e+1]; }
        ss+=__shfl_xor(ss,1); ss+=__shfl_xor(ss,2); ss+=__shfl_xor(ss,4);
        const float rinv=1.0f/sqrtf(ss*(1.0f/64.0f)+1e-6f);
        u32x4 w;
        #pragma unroll
        for(int e=0;e<4;++e)w[e]=cvtpk_s(dd[2*e]*rinv*sw[2*e],dd[2*e+1]*rinv*sw[2*e+1]);
        ATTN_STORE16(Ow+(long)row*DM+ch*8,w);} } }
  asm volatile("s_waitcnt lgkmcnt(0)\n\ts_barrier":::"memory");
  #undef DMA_K
  #undef DMA_V
  #undef CMASK
  #undef START
  #undef RESC
  #undef ROT
}
constexpr int ATTN_LDS_BYTES=LDS_BYTES;
struct AttnTensors { const bf16* Q; const bf16* K; const bf16* V; bf16* O; };
struct AttnUnit { int bh; int qb; };
struct StaticOrder {
  int vcu, G;
  __device__ __forceinline__ explicit StaticOrder(int grid,int block):vcu((grid%8==0)?(block%8)*(grid/8)+block/8:block),G(grid){}
  __device__ __forceinline__ bool next(int i,AttnUnit&u)const{ const int L=(i>>1)*G+vcu; if(L>=256)return false; const int s=L&7; u.bh=L>>3; u.qb=(i&1)?15-s:s; return true; }
};
template<class Sched,int THRL=8> __device__ __forceinline__ void attn_phase(char*lds,const AttnTensors&T,const Sched&S,float lam,const float*subw){
  AttnUnit u;
  for(int i=0;S.next(i,u);++i){
    attn_unit<THRL,0>(u.bh>>3,u.bh&7,u.qb,T.Q,T.K,T.V,T.O,lds,lam,subw);
    attn_unit<THRL,1>(u.bh>>3,u.bh&7,u.qb,T.Q,T.K,T.V,T.O,lds,lam,subw); }
}
#undef SBAR
#undef WAIT_BAR
}
constexpr int NWAVES = 8;
constexpr int BATCH = 4, SEQ = 4096, D = 1024, M = BATCH * SEQ;
constexpr int NIN = 2560, NQP = 2048, NEXP = 16384;
constexpr float NORM_EPS = 1e-6f, LN_EPS = 1e-5f;
#ifndef REP_PHASE
#define REP_PHASE 0
#endif
#define REP_COUNT 3
#define NREP(k) ((REP_PHASE == (k)) ? REP_COUNT : 1)
#ifndef STAGE
#define STAGE 9
#endif

constexpr size_t MiB = 1u << 20;
constexpr size_t WS_CTL = 0, CTL_ZERO_BYTES = 1 * MiB;
constexpr size_t WS_WIN = 1 * MiB, WS_WO = 6 * MiB, WS_WQ = 8 * MiB, WS_KEYS = 12 * MiB, WS_ROPE = 13 * MiB, WS_SS = 14 * MiB, WS_LNS = 15 * MiB, WS_WSB = 66 * MiB;
constexpr size_t WS_U8 = 16 * MiB, WS_V8 = 32 * MiB, WS_SU = 48 * MiB, WS_SV = 48 * MiB + 65536;
constexpr size_t WS_XN = 80 * MiB, WS_MIX = 80 * MiB;
constexpr size_t WS_SA2 = 12 * MiB + 576 * 1024, WS_SBQ = 12 * MiB + 800 * 1024, WS_A8 = 224 * MiB;
constexpr size_t WS_PM = 13 * MiB + 512 * 1024;
constexpr size_t WS_SA = 12 * MiB + 512 * 1024, WS_SB = 12 * MiB + 768 * 1024;
constexpr size_t WS_Q = 112 * MiB, WS_K = 144 * MiB, WS_V = 160 * MiB, WS_U = 176 * MiB, WS_VG = 192 * MiB;
constexpr size_t WS_X1B = 112 * MiB, WS_QP = 144 * MiB, WS_IDX = 208 * MiB, WS_G = 216 * MiB, WS_END = 240 * MiB;

constexpr int RING_OFF = 0, RING_BYTES = 131072;
constexpr int LDS_BYTES = 163840;
constexpr int LDSCTL_OFF = LDS_BYTES - 1024, MISC_OFF = LDSCTL_OFF + 320;
constexpr int CW_BAR = 4096;
#ifndef USE_CG_SYNC
#define USE_CG_SYNC 0
#endif
static_assert(attn_body::ATTN_LDS_BYTES <= RING_BYTES, "attention scratch inside the ring region");

#define GAS __attribute__((address_space(1)))
#define LAS __attribute__((address_space(3)))
typedef unsigned short bf16;
typedef unsigned v4u __attribute__((ext_vector_type(4)));
typedef float f32x4 __attribute__((ext_vector_type(4)));
typedef float f32x2v __attribute__((ext_vector_type(2)));
typedef float f32x16 __attribute__((ext_vector_type(16)));
typedef short bf16x8 __attribute__((ext_vector_type(8)));
#define LDS_WAIT() asm volatile("s_waitcnt lgkmcnt(0)" ::: "memory")
__device__ __forceinline__ unsigned f2bf(float f) { unsigned u = __builtin_bit_cast(unsigned, f); return (u + 0x7fffu + ((u >> 16) & 1u)) >> 16; }
__device__ __forceinline__ unsigned pk2(float lo, float hi) { return f2bf(lo) | (f2bf(hi) << 16); }
__device__ __forceinline__ float bflo(unsigned u) { return __uint_as_float(u << 16); }
__device__ __forceinline__ float bfhi(unsigned u) { return __uint_as_float(u & 0xffff0000u); }
__device__ __forceinline__ float wave_sum(float v) {
#pragma unroll
    for (int o = 1; o < 64; o <<= 1) v += __shfl_xor(v, o);
    return v;
}
__device__ __forceinline__ float vmaxf(float a, float b) { float r; asm("v_max_f32_e32 %0, %1, %2" : "=v"(r) : "v"(a), "v"(b)); return r; }
__device__ __forceinline__ float vminf(float a, float b) { float r; asm("v_min_f32_e32 %0, %1, %2" : "=v"(r) : "v"(a), "v"(b)); return r; }
__device__ __forceinline__ float gelu_exact(float v) { return 0.5f * v * (1.0f + erff(v * 0.70710678118654752f)); }

typedef GAS unsigned gu32;
#define RLX_AGENT __ATOMIC_RELAXED, __HIP_MEMORY_SCOPE_AGENT
#define XB_TMO      128
#define XB_XCNT(j)  (256  + 64 * (j))
#define XB_XSUB(j)  (1280 + 64 * (j))
#define XB_XGEN(j)  (2304 + 64 * (j))
#define XB_TOP      3328
#define XB_TOPGEN   3392
#define XCD_BAR_WORDS 3456
#define XB_SPIN_CAP (1u << 18)

__device__ __forceinline__ unsigned xb_ld(unsigned* p)              { return __hip_atomic_load(p, __ATOMIC_RELAXED, __HIP_MEMORY_SCOPE_AGENT); }
__device__ __forceinline__ unsigned xb_add(unsigned* p, unsigned v) { return __hip_atomic_fetch_add(p, v, __ATOMIC_RELAXED, __HIP_MEMORY_SCOPE_AGENT); }
__device__ __forceinline__ unsigned xb_xcc_id() { return (unsigned)__builtin_amdgcn_s_getreg((3 << 11) | 20) & 0xFu; }
#define XB_SPIN(cond, bar) do { unsigned _sp = 0; while (cond) { __builtin_amdgcn_s_sleep(1); \
    if ((++_sp & 255u) == 0u) { if (xb_ld(&(bar)[XB_TMO])) break; if (_sp > XB_SPIN_CAP) { atomicAdd(&(bar)[XB_TMO], 1u); break; } } } } while (0)

struct XcdBarrier {
    unsigned* bar; unsigned x;
    volatile LAS unsigned* st;
};

__device__ __forceinline__ XcdBarrier xcd_barrier_post(unsigned* bar, volatile LAS unsigned* st) {
    XcdBarrier b; b.bar = bar; b.x = xb_xcc_id(); b.st = st;
    if (threadIdx.x == 0) (void)xb_add(&bar[XB_XCNT(b.x)], 1u);
    return b;
}
__device__ __forceinline__ void xcd_barrier_complete(unsigned* bar, unsigned x, unsigned& nloc, unsigned& nx) {
    const unsigned G = gridDim.x * gridDim.y * gridDim.z;
    unsigned sum, cnt, mine, sp = 0u;
    for (;;) {
        sum = 0u; cnt = 0u; mine = 0u;
#pragma unroll
        for (unsigned j = 0; j < 16; ++j) { const unsigned c = xb_ld(&bar[XB_XCNT(j)]); sum += c; cnt += (c > 0u) ? 1u : 0u; mine = (j == x) ? c : mine; }
        if (sum == G) break;
        __builtin_amdgcn_s_sleep(1);
        if ((++sp & 255u) == 0u) { if (xb_ld(&bar[XB_TMO])) break; if (sp > XB_SPIN_CAP) { atomicAdd(&bar[XB_TMO], 1u); break; } }
    }
    nloc = mine > 0u ? mine : 1u; nx = cnt > 0u ? cnt : 1u;
}

__device__ __forceinline__ void xcd_barrier(const XcdBarrier& b) {
    asm volatile("s_waitcnt vmcnt(0)" ::: "memory");
    __syncthreads();
    if (threadIdx.x == 0) {
        unsigned* bar = b.bar;
        __builtin_amdgcn_s_waitcnt(0);
        unsigned nloc = b.st[0], nx = b.st[1];
        if (nloc == 0u) { xcd_barrier_complete(bar, b.x, nloc, nx); b.st[0] = nloc; b.st[1] = nx; }
        const unsigned old = xb_add(&bar[XB_XSUB(b.x)], 1u);
        const unsigned gen = old / nloc;
        if (old + 1u == (gen + 1u) * nloc) {
            __builtin_amdgcn_fence(__ATOMIC_RELEASE, "agent");
            asm volatile("s_waitcnt vmcnt(0)" ::: "memory");
            const unsigned og = xb_add(&bar[XB_TOP], 1u);
            const unsigned tg = og / nx;
            if (og + 1u == (tg + 1u) * nx) xb_add(&bar[XB_TOPGEN], 1u);
            else XB_SPIN(xb_ld(&bar[XB_TOPGEN]) == tg, bar);
            __builtin_amdgcn_fence(__ATOMIC_ACQUIRE, "agent");
            xb_add(&bar[XB_XGEN(b.x)], 1u);
            asm volatile("s_waitcnt vmcnt(0)" ::: "memory");
        } else {
            XB_SPIN(xb_ld(&bar[XB_XGEN(b.x)]) == gen, bar);
            __builtin_amdgcn_fence(__ATOMIC_ACQUIRE, "agent");
            asm volatile("s_waitcnt vmcnt(0)" ::: "memory");
        }
    }
    __syncthreads();
}

struct Args { const float* in[20]; float* out; unsigned char* ws; };
struct Frame {
    LAS unsigned char* lds;
    int tid, lane, wave, vcu, G;
    float* out; unsigned char* ws;
};

__device__ __forceinline__ void frame_refresh(Frame& F) { int t = threadIdx.x; asm volatile("" : "+v"(t)); F.tid = t; F.lane = t & 63; F.wave = __builtin_amdgcn_readfirstlane(t >> 6); }
__device__ __forceinline__ void p0_transpose_item(const float* W, int K, int N, bf16* WT, LAS float* scr, int item, int lane, const float* kscale) {
    const int nblk = N / 32, kb = item / nblk, nb = item % nblk, k0 = 64 * kb, n0 = 32 * nb;
#pragma unroll 8
    for (int i = 0; i < 32; ++i) { const int kk = 2 * i + (lane >> 5); float v = W[(size_t)(k0 + kk) * N + n0 + (lane & 31)]; if (kscale) v *= kscale[k0 + kk]; scr[kk * 33 + (lane & 31)] = v; }
    LDS_WAIT(); asm volatile("" ::: "memory");
    const int c = lane & 7;
#pragma unroll
    for (int j = 0; j < 4; ++j) { const int n = (lane >> 3) + 8 * j; const LAS float* s = scr + (8 * c) * 33 + n;
        v4u o; o.x = pk2(s[0 * 33], s[1 * 33]); o.y = pk2(s[2 * 33], s[3 * 33]); o.z = pk2(s[4 * 33], s[5 * 33]); o.w = pk2(s[6 * 33], s[7 * 33]);
        *(GAS v4u*)(WT + (size_t)(n0 + n) * K + k0 + 8 * c) = o; }
    LDS_WAIT(); asm volatile("" ::: "memory");
}
__device__ __forceinline__ unsigned pack4_i8(float a, float b, float c, float d) {
    const int qa = __float2int_rn(a), qb = __float2int_rn(b), qc = __float2int_rn(c), qd = __float2int_rn(d);
    return (unsigned)(qa & 255) | ((unsigned)(qb & 255) << 8) | ((unsigned)(qc & 255) << 16) | ((unsigned)qd << 24);
}
__device__ __forceinline__ void rms_row_to_bf16(const float* xrow, const float* w, bf16* orow, int lane) {
    const GAS f32x4* xr = (const GAS f32x4*)xrow + lane; const GAS f32x4* wr = (const GAS f32x4*)w + lane;
    f32x4 v[4]; float s = 0.f;
#pragma unroll
    for (int j = 0; j < 4; ++j) { v[j] = xr[64 * j]; s += (v[j].x * v[j].x + v[j].y * v[j].y) + (v[j].z * v[j].z + v[j].w * v[j].w); }
    const float r = 1.f / sqrtf(wave_sum(s) * (1.f / D) + NORM_EPS);
    GAS unsigned long long* o8 = (GAS unsigned long long*)orow + lane;
#pragma unroll
    for (int j = 0; j < 4; ++j) { const f32x4 g = wr[64 * j]; o8[64 * j] = (unsigned long long)pk2(v[j].x * r * g.x, v[j].y * r * g.y) | ((unsigned long long)pk2(v[j].z * r * g.z, v[j].w * r * g.w) << 32); }
}
__device__ __forceinline__ void rms_row_to_i8(const float* xrow, const float* w, unsigned char* orow, float* sa, int lane) {
    const GAS f32x4* xr = (const GAS f32x4*)xrow + lane; const GAS f32x4* wr = (const GAS f32x4*)w + lane;
    f32x4 v[4]; float s = 0.f;
#pragma unroll
    for (int j = 0; j < 4; ++j) { v[j] = xr[64 * j]; s += (v[j].x * v[j].x + v[j].y * v[j].y) + (v[j].z * v[j].z + v[j].w * v[j].w); }
    const float r = 1.f / sqrtf(wave_sum(s) * (1.f / D) + NORM_EPS);
    float am = 0.f;
#pragma unroll
    for (int j = 0; j < 4; ++j) { const f32x4 g = wr[64 * j]; v[j].x *= r * g.x; v[j].y *= r * g.y; v[j].z *= r * g.z; v[j].w *= r * g.w;
        am = fmaxf(am, fmaxf(fmaxf(fabsf(v[j].x), fabsf(v[j].y)), fmaxf(fabsf(v[j].z), fabsf(v[j].w)))); }
#pragma unroll
    for (int o = 1; o < 64; o <<= 1) am = fmaxf(am, __shfl_xor(am, o));
    const float sc = am > 0.f ? am * (1.f / 127.f) : 1.f, inv = 1.f / sc;
    GAS unsigned* o4 = (GAS unsigned*)orow + lane;
#pragma unroll
    for (int j = 0; j < 4; ++j) o4[64 * j] = pack4_i8(v[j].x * inv, v[j].y * inv, v[j].z * inv, v[j].w * inv);
    if (lane == 0) *sa = sc;
}
__device__ __forceinline__ void cvt_f32_bf16(const float* src, bf16* dst, size_t n8, size_t gtid, size_t nthr) {
    for (size_t i = gtid; i < n8; i += nthr) { const f32x4 a = *(const GAS f32x4*)(src + i * 8), b = *(const GAS f32x4*)(src + i * 8 + 4);
        v4u o; o.x = pk2(a.x, a.y); o.y = pk2(a.z, a.w); o.z = pk2(b.x, b.y); o.w = pk2(b.z, b.w); *(GAS v4u*)(dst + i * 8) = o; }
}
__device__ __forceinline__ void fp8_table_row(Frame& F, const Args& args, int r) {
    const int tb = r >= NEXP, e = r - tb * NEXP;
    const float* src = args.in[17 + tb] + (size_t)e * D + 16 * F.lane;
    const f32x4 a = *(const GAS f32x4*)src, b = *(const GAS f32x4*)(src + 4), c = *(const GAS f32x4*)(src + 8), d = *(const GAS f32x4*)(src + 12);
    float am = fmaxf(fmaxf(fmaxf(fabsf(a.x), fabsf(a.y)), fmaxf(fabsf(a.z), fabsf(a.w))), fmaxf(fmaxf(fabsf(b.x), fabsf(b.y)), fmaxf(fabsf(b.z), fabsf(b.w))));
    am = fmaxf(am, fmaxf(fmaxf(fmaxf(fabsf(c.x), fabsf(c.y)), fmaxf(fabsf(c.z), fabsf(c.w))), fmaxf(fmaxf(fabsf(d.x), fabsf(d.y)), fmaxf(fabsf(d.z), fabsf(d.w)))));
#pragma unroll
    for (int o = 1; o < 64; o <<= 1) am = fmaxf(am, __shfl_xor(am, o));
    const float sc = am > 0.f ? am * (1.f / 224.f) : 1.f, inv = 1.f / sc;
    v4u w; int t;
    t = __builtin_amdgcn_cvt_pk_fp8_f32(a.x * inv, a.y * inv, 0, false); t = __builtin_amdgcn_cvt_pk_fp8_f32(a.z * inv, a.w * inv, t, true); w.x = (unsigned)t;
    t = __builtin_amdgcn_cvt_pk_fp8_f32(b.x * inv, b.y * inv, 0, false); t = __builtin_amdgcn_cvt_pk_fp8_f32(b.z * inv, b.w * inv, t, true); w.y = (unsigned)t;
    t = __builtin_amdgcn_cvt_pk_fp8_f32(c.x * inv, c.y * inv, 0, false); t = __builtin_amdgcn_cvt_pk_fp8_f32(c.z * inv, c.w * inv, t, true); w.z = (unsigned)t;
    t = __builtin_amdgcn_cvt_pk_fp8_f32(d.x * inv, d.y * inv, 0, false); t = __builtin_amdgcn_cvt_pk_fp8_f32(d.z * inv, d.w * inv, t, true); w.w = (unsigned)t;
    *(GAS v4u*)(F.ws + (tb ? WS_V8 : WS_U8) + (size_t)(F.lane >> 3) * ((size_t)NEXP * 128) + (size_t)e * 128 + 16 * (F.lane & 7)) = w;
    if (F.lane == 0) ((float*)(F.ws + (tb ? WS_SV : WS_SU)))[e] = sc;
}
__device__ __forceinline__ void int8_table_row(Frame& F, const Args& args, int r, const f32x4 (&fw4)[4]) {
    const int tb = r >= NEXP, e = r - tb * NEXP;
    const float* src = args.in[17 + tb] + (size_t)e * D + 16 * F.lane;
    f32x4 a = *(const GAS f32x4*)src, b = *(const GAS f32x4*)(src + 4), c = *(const GAS f32x4*)(src + 8), d = *(const GAS f32x4*)(src + 12);
    if (!tb) { a *= fw4[0]; b *= fw4[1]; c *= fw4[2]; d *= fw4[3]; }
    float am = fmaxf(fmaxf(fmaxf(fabsf(a.x), fabsf(a.y)), fmaxf(fabsf(a.z), fabsf(a.w))), fmaxf(fmaxf(fabsf(b.x), fabsf(b.y)), fmaxf(fabsf(b.z), fabsf(b.w))));
    am = fmaxf(am, fmaxf(fmaxf(fmaxf(fabsf(c.x), fabsf(c.y)), fmaxf(fabsf(c.z), fabsf(c.w))), fmaxf(fmaxf(fabsf(d.x), fabsf(d.y)), fmaxf(fabsf(d.z), fabsf(d.w)))));
#pragma unroll
    for (int o = 1; o < 64; o <<= 1) am = fmaxf(am, __shfl_xor(am, o));
    const float sc = am > 0.f ? am * (1.f / 127.f) : 1.f, inv = 1.f / sc;
    v4u w; w.x = pack4_i8(a.x * inv, a.y * inv, a.z * inv, a.w * inv); w.y = pack4_i8(b.x * inv, b.y * inv, b.z * inv, b.w * inv);
    w.z = pack4_i8(c.x * inv, c.y * inv, c.z * inv, c.w * inv); w.w = pack4_i8(d.x * inv, d.y * inv, d.z * inv, d.w * inv);
    *(GAS v4u*)(F.ws + (tb ? WS_V8 : WS_U8) + (size_t)(F.lane >> 3) * ((size_t)NEXP * 128) + (size_t)e * 128 + 16 * (F.lane & 7)) = w;
    if (F.lane == 0) ((float*)(F.ws + (tb ? WS_SV : WS_SU)))[e] = sc;
}
__device__ __forceinline__ void p0_win_strip(Frame& F, const float* W0, int N, const float* kscale, unsigned char* WT0, float* SBd, int strip) {
    LAS float* scr = (LAS float*)(F.lds + RING_OFF); LAS float* pm = scr + 1024 * 33;
    const float* W = W0 + 32 * strip; const int c = F.tid & 31, part = F.tid >> 5;
#pragma unroll 1
    for (int h = 0; h < 2; ++h) { float t[32];
#pragma unroll
      for (int i = 0; i < 32; ++i) t[i] = W[(size_t)((h * 32 + i) * 16 + part) * N + c];
#pragma unroll
      for (int i = 0; i < 32; ++i) { const int k = (h * 32 + i) * 16 + part; float v = t[i]; if (kscale) v *= kscale[k]; scr[k * 33 + c] = v; } }
    __syncthreads();
    { float am = 0.f;
#pragma unroll 8
      for (int i = 0; i < 64; ++i) am = fmaxf(am, fabsf(scr[(part * 64 + i) * 33 + c]));
      pm[part * 32 + c] = am; }
    __syncthreads();
    float am = 0.f;
#pragma unroll
    for (int p = 0; p < 16; ++p) am = fmaxf(am, pm[p * 32 + c]);
    const float sc = am > 0.f ? am * (1.f / 127.f) : 1.f, inv = 1.f / sc;
    if (part == 0) SBd[32 * strip + c] = sc;
    unsigned char* WT = WT0 + (size_t)(32 * strip + c) * D;
#pragma unroll
    for (int j = 0; j < 4; ++j) { const int kc = part + 16 * j; const LAS float* p = scr + (16 * kc) * 33 + c;
        v4u o; o.x = pack4_i8(p[0 * 33] * inv, p[1 * 33] * inv, p[2 * 33] * inv, p[3 * 33] * inv); o.y = pack4_i8(p[4 * 33] * inv, p[5 * 33] * inv, p[6 * 33] * inv, p[7 * 33] * inv);
        o.z = pack4_i8(p[8 * 33] * inv, p[9 * 33] * inv, p[10 * 33] * inv, p[11 * 33] * inv); o.w = pack4_i8(p[12 * 33] * inv, p[13 * 33] * inv, p[14 * 33] * inv, p[15 * 33] * inv);
        *(GAS v4u*)(WT + 16 * kc) = o; }
    __syncthreads();
}
__device__ __forceinline__ void p0_prologue(Frame& F, const Args& args) {
    LAS float* scr = (LAS float*)(F.lds + RING_OFF + F.wave * 16384);
    const int gw = F.vcu * NWAVES + F.wave, NGW = F.G * NWAVES;
    constexpr int I_IN = (D / 64) * (NIN / 32), I_O = (D / 64) * (D / 32), I_Q = (D / 64) * (NQP / 32);
    constexpr int NSTRIP_IN = NIN / 32, NSTRIP = NSTRIP_IN + NQP / 32, NITEMS = I_O;
    static_assert(I_IN > 0 && I_Q > 0 && NSTRIP == 144, "strip split");
    const bool stripwg = F.vcu < NSTRIP;
    if (F.vcu < NSTRIP_IN) p0_win_strip(F, args.in[2], NIN, nullptr, F.ws + WS_WIN, (float*)(F.ws + WS_SB), F.vcu);
    else if (stripwg) p0_win_strip(F, args.in[15], NQP, args.in[14], F.ws + WS_WQ, (float*)(F.ws + WS_SBQ), F.vcu - NSTRIP_IN);
    else {
        const int gw2 = (F.vcu - NSTRIP) * NWAVES + F.wave, NGW2 = (F.G - NSTRIP) * NWAVES;
        for (int it = gw2; it < NITEMS; it += NGW2) {
            int r = it;
            p0_transpose_item(args.in[13], D, D, (bf16*)(F.ws + WS_WO), scr, r, F.lane, nullptr);
        }
        for (int m = 5 * NGW + gw2; m < M; m += NGW2) rms_row_to_i8(args.in[0] + (size_t)m * D, args.in[1], F.ws + WS_XN + (size_t)m * D, (float*)(F.ws + WS_SA) + m, F.lane);
    }
    for (int m = gw; m < 5 * NGW; m += NGW) rms_row_to_i8(args.in[0] + (size_t)m * D, args.in[1], F.ws + WS_XN + (size_t)m * D, (float*)(F.ws + WS_SA) + m, F.lane);
    const size_t gtid = (size_t)F.vcu * (NWAVES * 64) + F.tid, nthr = (size_t)F.G * (NWAVES * 64);
    { const f32x4 one4[4] = {{1.f, 1.f, 1.f, 1.f}, {1.f, 1.f, 1.f, 1.f}, {1.f, 1.f, 1.f, 1.f}, {1.f, 1.f, 1.f, 1.f}}; for (int r = NEXP + gw; r < 2 * NEXP; r += NGW) int8_table_row(F, args, r, one4); }
    cvt_f32_bf16(args.in[16], (bf16*)(F.ws + WS_KEYS), (size_t)2 * 128 * 128 / 8, gtid, nthr);
    for (size_t i = gtid; i < (size_t)M; i += nthr) ((GAS v4u*)(F.ws + WS_PM))[i] = (v4u){0u, 0u, 0u, 0u};
    for (size_t i = gtid; i < (size_t)8 * 128 * 128 / 8; i += nthr) {
        const int t = (int)((i >> 4) & 127), s0 = (int)(i & 15) * 8; const f32x4 a = *(const GAS f32x4*)(args.in[10] + i * 8), b = *(const GAS f32x4*)(args.in[10] + i * 8 + 4);
        v4u o; o.x = pk2(s0 + 0 <= t ? a.x : 0.f, s0 + 1 <= t ? a.y : 0.f); o.y = pk2(s0 + 2 <= t ? a.z : 0.f, s0 + 3 <= t ? a.w : 0.f); o.z = pk2(s0 + 4 <= t ? b.x : 0.f, s0 + 5 <= t ? b.y : 0.f); o.w = pk2(s0 + 6 <= t ? b.z : 0.f, s0 + 7 <= t ? b.w : 0.f);
        *(GAS v4u*)((bf16*)(F.ws + WS_WSB) + i * 8) = o; }
    float* rope = (float*)(F.ws + WS_ROPE);
    for (size_t e = gtid; e < (size_t)SEQ * 16; e += nthr) {
        const int pos = (int)(e >> 4), f = (int)(e & 15), f4 = f & 3, fd = f >> 2;
        float inv = (f4 == 0) ? 1.0f : (f4 == 1) ? 5.623413252e-01f : (f4 == 2) ? 3.162277660e-01f : 1.778279410e-01f;
        inv *= (fd == 0) ? 1.0f : (fd == 1) ? 0.1f : (fd == 2) ? 0.01f : 0.001f;
        const float ang = (float)pos * inv;
        const double rev = (double)ang * 0.15915494309189533577; const float fr = (float)(rev - floor(rev));
        rope[2 * e] = __builtin_amdgcn_cosf(fr); rope[2 * e + 1] = __builtin_amdgcn_sinf(fr);
    }
}

__device__ __forceinline__ int crow32(int r, int hi) { return (r & 3) + 8 * (r >> 2) + 4 * hi; }
__device__ __forceinline__ void sgu_item(Frame& F, const Args& args, int chunk, int hg) {
    constexpr int VROW = 272;
    LAS f32x2v* ST = (LAS f32x2v*)(F.lds + RING_OFF);
    LAS unsigned char* VT = F.lds + RING_OFF + 1024;
    const bf16* VG = (const bf16*)(F.ws + WS_VG); const bf16* U = (const bf16*)(F.ws + WS_U); bf16* MIX = (bf16*)(F.ws + WS_MIX);
    const int row0 = chunk * 128, lane = F.lane;
    if (F.tid < 128) { const float* lp = (const float*)(F.ws + WS_LNS) + (size_t)(row0 + F.tid) * 16; float s1 = 0.f, s2 = 0.f;
#pragma unroll
        for (int q = 0; q < 4; ++q) { const f32x4 v = *(const GAS f32x4*)(lp + 4 * q); s1 += v.x + v.z; s2 += v.y + v.w; }
        const float mean = s1 * (1.f / 512.f), var = fmaxf(s2 * (1.f / 512.f) - mean * mean, 0.f);
        ST[F.tid] = (f32x2v){mean, 1.f / sqrtf(var + LN_EPS)}; }
    __syncthreads();
#pragma unroll 4
    for (int k = 0; k < 8; ++k) { const int task = F.wave * 8 + k, hl = task >> 4, sb = task & 15, ch = (hg * 4 + hl) * 64 + lane;
        const float lw = args.in[8][ch], lb = args.in[9][ch];
        float y[8];
#pragma unroll
        for (int e = 0; e < 8; ++e) { const int sidx = sb * 8 + e; const float v = __uint_as_float((unsigned)VG[(size_t)(row0 + sidx) * 512 + ch] << 16); const f32x2v st = ST[sidx]; y[e] = (v - st.x) * st.y * lw + lb; }
        *(LAS v4u*)(VT + (hl * 64 + lane) * VROW + sb * 16) = (v4u){pk2(y[0], y[1]), pk2(y[2], y[3]), pk2(y[4], y[5]), pk2(y[6], y[7])}; }
    __syncthreads();
    const int hl = F.wave & 3, th = F.wave >> 2, h = hg * 4 + hl, r32 = lane & 31, hi = lane >> 5;
    const bf16* Wh = (const bf16*)(F.ws + WS_WSB) + (size_t)h * 128 * 128;
    const float onw0 = 0.f; (void)onw0;
#pragma unroll
    for (int ti = 0; ti < 2; ++ti) {
        const int T = 2 * th + ti, t = 32 * T + r32;
        f32x16 acc0 = {}, acc1 = {};
        const bf16* wrow = Wh + (size_t)t * 128 + 8 * hi;
        const LAS unsigned char* va = VT + (hl * 64 + r32) * VROW + 16 * hi;
        for (int ks = 0; ks < 2 * T + 2; ++ks) {
            const bf16x8 bfrag = *(const GAS bf16x8*)(wrow + 16 * ks);
            const bf16x8 a0 = *(const LAS bf16x8*)(va + 32 * ks), a1 = *(const LAS bf16x8*)(va + 32 * VROW + 32 * ks);
            acc0 = __builtin_amdgcn_mfma_f32_32x32x16_bf16(a0, bfrag, acc0, 0, 0, 0);
            acc1 = __builtin_amdgcn_mfma_f32_32x32x16_bf16(a1, bfrag, acc1, 0, 0, 0);
        }
        const size_t row = (size_t)(row0 + t); const float bias = args.in[11][h * 128 + t];
        const bf16* up = U + row * 512 + h * 64 + 4 * hi; bf16* op = MIX + row * 1024 + 512 + h * 64 + 4 * hi; const float* nw = args.in[12] + h * 64 + 4 * hi;
        float o[32]; float ssq = 0.f;
#pragma unroll
        for (int di = 0; di < 2; ++di)
#pragma unroll
            for (int g = 0; g < 4; ++g) { const f32x2v uu = *(const GAS f32x2v*)(up + 32 * di + 8 * g); const unsigned u0 = __float_as_uint(uu.x), u1 = __float_as_uint(uu.y);
                const float m0 = (di ? acc1[4 * g] : acc0[4 * g]) + bias, m1 = (di ? acc1[4 * g + 1] : acc0[4 * g + 1]) + bias, m2 = (di ? acc1[4 * g + 2] : acc0[4 * g + 2]) + bias, m3 = (di ? acc1[4 * g + 3] : acc0[4 * g + 3]) + bias;
                const float o0 = bflo(u0) * m0, o1 = bfhi(u0) * m1, o2 = bflo(u1) * m2, o3 = bfhi(u1) * m3;
                o[di * 16 + 4 * g] = o0; o[di * 16 + 4 * g + 1] = o1; o[di * 16 + 4 * g + 2] = o2; o[di * 16 + 4 * g + 3] = o3; ssq += (o0 * o0 + o1 * o1) + (o2 * o2 + o3 * o3); }
        ssq += __shfl_xor(ssq, 32);
        const float rn = 1.f / sqrtf(ssq * (1.f / 64.f) + NORM_EPS);
#pragma unroll
        for (int di = 0; di < 2; ++di)
#pragma unroll
            for (int g = 0; g < 4; ++g) { const f32x4 wv = *(const GAS f32x4*)(nw + 32 * di + 8 * g); const int b = di * 16 + 4 * g;
                f32x2v pk; pk.x = __uint_as_float(pk2(o[b] * rn * wv.x, o[b + 1] * rn * wv.y)); pk.y = __uint_as_float(pk2(o[b + 2] * rn * wv.z, o[b + 3] * rn * wv.w));
                *(GAS f32x2v*)(op + 32 * di + 8 * g) = pk; }
    }
    __syncthreads();
}

#define CE16(X, i, j) { const float a_ = X[i], b_ = X[j]; X[i] = vmaxf(a_, b_); X[j] = vminf(a_, b_); }
#define SORT16(X) do { CE16(X,0,1) CE16(X,2,3) CE16(X,0,2) CE16(X,1,3) CE16(X,1,2) CE16(X,4,5) CE16(X,6,7) CE16(X,4,6) CE16(X,5,7) CE16(X,5,6) CE16(X,0,4) CE16(X,2,6) CE16(X,2,4) CE16(X,1,5) CE16(X,3,7) CE16(X,3,5) CE16(X,1,2) CE16(X,3,4) CE16(X,5,6) CE16(X,8,9) CE16(X,10,11) CE16(X,8,10) CE16(X,9,11) CE16(X,9,10) CE16(X,12,13) CE16(X,14,15) CE16(X,12,14) CE16(X,13,15) CE16(X,13,14) CE16(X,8,12) CE16(X,10,14) CE16(X,10,12) CE16(X,9,13) CE16(X,11,15) CE16(X,11,13) CE16(X,9,10) CE16(X,11,12) CE16(X,13,14) CE16(X,0,8) CE16(X,4,12) CE16(X,4,8) CE16(X,2,10) CE16(X,6,14) CE16(X,6,10) CE16(X,2,4) CE16(X,6,8) CE16(X,10,12) CE16(X,1,9) CE16(X,5,13) CE16(X,5,9) CE16(X,3,11) CE16(X,7,15) CE16(X,7,11) CE16(X,3,5) CE16(X,7,9) CE16(X,11,13) CE16(X,1,2) CE16(X,3,4) CE16(X,5,6) CE16(X,7,8) CE16(X,9,10) CE16(X,11,12) CE16(X,13,14) } while (0)
#define MERGE16(T, X) do { _Pragma("unroll") for (int q_ = 0; q_ < 16; ++q_) T[q_] = vmaxf(T[q_], X[15 - q_]); \
    _Pragma("unroll") for (int st_ = 8; st_ >= 1; st_ >>= 1) _Pragma("unroll") for (int q_ = 0; q_ < 16; ++q_) if ((q_ & st_) == 0) CE16(T, q_, q_ + st_) } while (0)
#define INS16(T, X) do { _Pragma("unroll") for (int q_ = 0; q_ < 16; ++q_) { const float h_ = vmaxf(T[q_], X); X = vminf(T[q_], X); T[q_] = h_; } } while (0)
__device__ __forceinline__ void p5_unit(Frame& F, int row0) {
    LAS unsigned char* KL = F.lds + RING_OFF;
    LAS float* TV = (LAS float*)(F.lds + RING_OFF + 65536);
    const bf16* QP = (const bf16*)(F.ws + WS_QP); const bf16* KB = (const bf16*)(F.ws + WS_KEYS);
    const int lane = F.lane, r32 = lane & 31, hi = lane >> 5;
#define P5_QLOAD(QF, kk) do { const int task_ = F.wave * 4 + (kk), hl_ = task_ >> 2, c_ = (task_ >> 1) & 1, tg_ = task_ & 1; \
        const bf16* qrow_ = QP + (size_t)(row0 + tg_ * 32 + r32) * NQP + hl_ * 256 + c_ * 128 + hi * 8; \
        _Pragma("unroll") for (int ks = 0; ks < 8; ++ks) QF[ks] = *(const GAS bf16x8*)(qrow_ + ks * 16); } while (0)
    bf16x8 qfA[8], qfB[8], qfC[8], qfD[8];
    P5_QLOAD(qfA, 0); P5_QLOAD(qfB, 1); P5_QLOAD(qfC, 2); P5_QLOAD(qfD, 3);
#pragma unroll
    for (int i = 0; i < 8; ++i) { const int chunk = F.tid + i * 512, ck = chunk >> 4, ch = chunk & 15;
        *(LAS v4u*)(KL + ck * 256 + ((ch ^ (ck & 15)) << 4)) = *(const GAS v4u*)(KB + (size_t)chunk * 8); }
    __syncthreads();
#pragma unroll
    for (int k = 0; k < 4; ++k) {
        const int task = F.wave * 4 + k, hl = task >> 2, c = (task >> 1) & 1, tg = task & 1;
        bf16x8 (&qf)[8] = (k == 0) ? qfA : (k == 1) ? qfB : (k == 2) ? qfC : qfD;
        float t[16];
#pragma unroll
        for (int i = 0; i < 4; ++i) {
            f32x16 acc = {};
#pragma unroll
            for (int ks = 0; ks < 8; ++ks) { const int key = 32 * i + r32; const bf16x8 a = *(const LAS bf16x8*)(KL + (c * 128 + key) * 256 + (((2 * ks + hi) ^ (key & 15)) << 4)); acc = __builtin_amdgcn_mfma_f32_32x32x16_bf16(a, qf[ks], acc, 0, 0, 0); }
            float x[16];
#pragma unroll
            for (int r = 0; r < 16; ++r) { const unsigned key = (unsigned)(32 * i + (r & 3) + 8 * (r >> 2)) | (unsigned)(4 * hi);
                x[r] = __uint_as_float((__float_as_uint(acc[r]) & ~0x7fu) | key); }
            SORT16(x);
            if (i == 0) {
#pragma unroll
                for (int q = 0; q < 16; ++q) t[q] = x[q];
            } else MERGE16(t, x);
        }
        float m[16];
#pragma unroll
        for (int q = 0; q < 16; ++q) { const float p = __shfl_xor(t[15 - q], 32); m[q] = vmaxf(t[q], p); }
#pragma unroll
        for (int st = 8; st >= 1; st >>= 1)
#pragma unroll
            for (int q = 0; q < 16; ++q) if ((q & st) == 0) { const float a = m[q], b = m[q + st]; m[q] = vmaxf(a, b); m[q + st] = vminf(a, b); }
        if (hi == 0) { LAS f32x4* dst = (LAS f32x4*)(TV + ((hl * 2 + c) * 64 + tg * 32 + r32) * 20);
#pragma unroll
            for (int q = 0; q < 4; ++q) dst[q] = (f32x4){m[4 * q], m[4 * q + 1], m[4 * q + 2], m[4 * q + 3]}; }
    }
#undef P5_QLOAD
    __syncthreads();
    {
        const int tok = F.tid & 63, hl = F.tid >> 6, head = hl; const size_t row = (size_t)(row0 + tok);
        const LAS float* pa = TV + ((hl * 2 + 0) * 64 + tok) * 20; const LAS float* pb = TV + ((hl * 2 + 1) * 64 + tok) * 20;
        float a[16], b[16];
#pragma unroll
        for (int q = 0; q < 4; ++q) { const f32x4 va = ((const LAS f32x4*)pa)[q], vb = ((const LAS f32x4*)pb)[q];
            a[4 * q] = va.x; a[4 * q + 1] = va.y; a[4 * q + 2] = va.z; a[4 * q + 3] = va.w; b[4 * q] = vb.x; b[4 * q + 1] = vb.y; b[4 * q + 2] = vb.z; b[4 * q + 3] = vb.w; }
        float t[16], x[16];
#define CAND(i, j) __uint_as_float((__float_as_uint(a[i] + b[j]) & ~0xffu) | (unsigned)((i) * 16 + (j)))
        t[0] = CAND(0, 0); t[1] = CAND(0, 1); t[2] = CAND(0, 2); t[3] = CAND(0, 3); t[4] = CAND(0, 4); t[5] = CAND(0, 5); t[6] = CAND(0, 6); t[7] = CAND(0, 7);
        t[8] = CAND(0, 8); t[9] = CAND(0, 9); t[10] = CAND(0, 10); t[11] = CAND(0, 11); t[12] = CAND(0, 12); t[13] = CAND(0, 13); t[14] = CAND(0, 14); t[15] = CAND(0, 15);
        SORT16(t);
        x[0] = CAND(1, 0); x[1] = CAND(1, 1); x[2] = CAND(1, 2); x[3] = CAND(1, 3); x[4] = CAND(1, 4); x[5] = CAND(1, 5); x[6] = CAND(1, 6); x[7] = CAND(1, 7);
        x[8] = CAND(2, 0); x[9] = CAND(2, 1); x[10] = CAND(2, 2); x[11] = CAND(2, 3); x[12] = CAND(2, 4); x[13] = CAND(3, 0); x[14] = CAND(3, 1); x[15] = CAND(3, 2);
        SORT16(x); MERGE16(t, x);
        x[0] = CAND(3, 3); x[1] = CAND(4, 0); x[2] = CAND(4, 1); x[3] = CAND(4, 2); x[4] = CAND(5, 0); x[5] = CAND(5, 1); x[6] = CAND(6, 0); x[7] = CAND(6, 1);
        x[8] = CAND(7, 0); x[9] = CAND(7, 1); x[10] = CAND(8, 0); x[11] = CAND(9, 0); x[12] = CAND(10, 0); x[13] = CAND(11, 0); x[14] = CAND(12, 0); x[15] = CAND(13, 0);
        SORT16(x); MERGE16(t, x);
        { float y0 = CAND(14, 0); INS16(t, y0); float y1 = CAND(15, 0); INS16(t, y1); }
#undef CAND
        const float* ssp = (const float*)(F.ws + WS_SS) + row * 16; float ss = 0.f;
#pragma unroll
        for (int q = 0; q < 4; ++q) { const f32x4 v = *(const GAS f32x4*)(ssp + 4 * q); ss += (v.x + v.y) + (v.z + v.w); }
        const float r2 = 1.f / sqrtf(ss * (1.f / D) + NORM_EPS);
        const float kq = r2 * 1.4426950408889634f; const float v0 = __uint_as_float(__float_as_uint(t[0]) & ~0xffu);
        float g[16]; float gs = 0.f;
#pragma unroll
        for (int q = 0; q < 16; ++q) { const float v = __uint_as_float(__float_as_uint(t[q]) & ~0xffu); g[q] = __builtin_amdgcn_exp2f((v - v0) * kq); gs += g[q]; }
        const float gi = 1.f / gs;
        int* IDX = (int*)(F.ws + WS_IDX) + row * 128 + head * 16; float* G = (float*)(F.ws + WS_G) + row * 128 + head * 16;
#pragma unroll
        for (int q = 0; q < 4; ++q) { int e[4];
#pragma unroll
            for (int z = 0; z < 4; ++z) { const unsigned ij = __float_as_uint(t[4 * q + z]) & 0xffu; const unsigned e1 = __float_as_uint(pa[ij >> 4]) & 0x7fu, e2 = __float_as_uint(pb[ij & 15]) & 0x7fu; e[z] = (int)(e1 * 128u + e2); }
            *(GAS v4u*)(IDX + 4 * q) = (v4u){(unsigned)e[0], (unsigned)e[1], (unsigned)e[2], (unsigned)e[3]};
            *(GAS f32x4*)(G + 4 * q) = (f32x4){g[4 * q] * gi, g[4 * q + 1] * gi, g[4 * q + 2] * gi, g[4 * q + 3] * gi}; }
    }
    __syncthreads();
}

#define DPP_F(x, ctrl) __uint_as_float((unsigned)__builtin_amdgcn_update_dpp(0, (int)__float_as_uint(x), ctrl, 0xf, 0xf, false))
#define DPP_I(x, ctrl) __builtin_amdgcn_update_dpp(0, (x), ctrl, 0xf, 0xf, false)
#define DPP_HALF_MIRROR 0x141
#define DPP_XOR2 0x4E
#define DPP_XOR1 0xB1
#define DPP_ROR8 0x128
typedef float f32x2p __attribute__((ext_vector_type(2)));
typedef _Float16 h16x2 __attribute__((ext_vector_type(2)));
typedef __bf16 b16x2 __attribute__((ext_vector_type(2)));
#define FP8X2(w, hi) __builtin_amdgcn_cvt_pk_f32_fp8((int)(w), hi)
__device__ __forceinline__ void p6_tail(Frame& F, const Args& args) {
    const int lane = F.lane, j = blockIdx.x & 7, gwv = (blockIdx.x >> 3) * NWAVES + F.wave, sg = lane >> 3, cg = lane & 7;
    const int tok0 = j * 2048 + gwv * 8;
    constexpr size_t SLICE = (size_t)NEXP * 128;
    const unsigned char* U8 = F.ws + WS_U8; const unsigned char* V8 = F.ws + WS_V8; const unsigned loff = 16u * cg;
    int i0[8], i1[8];
#pragma unroll
    for (int tk = 0; tk < 8; ++tk) { const int* ip = (const int*)(F.ws + WS_IDX) + (size_t)(tok0 + tk) * 128 + lane; i0[tk] = ip[0]; i1[tk] = ip[64]; }
    v4u buf[16];
    unsigned nid[16];
#define T_IDS(tkn) do { _Pragma("unroll") for (int it_ = 0; it_ < 16; ++it_) nid[it_] = (unsigned)__shfl(it_ < 8 ? i0[tkn] : i1[tkn], (it_ & 7) * 8 + sg) * 128u + loff; } while (0)
#define T_LOAD(BASE, it) do { buf[it] = *(const GAS v4u*)((BASE) + nid[it]); } while (0)
    LAS unsigned char* hq = F.lds + RING_OFF + F.wave * 8192;
    float sh[8];
    {
        const unsigned char* a8 = F.ws + WS_A8 + (size_t)tok0 * D + 16 * lane; const float* sa2 = (const float*)(F.ws + WS_SA2) + tok0;
#pragma unroll
        for (int tk = 0; tk < 8; ++tk) { *(LAS v4u*)(hq + tk * 1024 + 16 * lane) = *(const GAS v4u*)(a8 + (size_t)tk * D); sh[tk] = sa2[tk]; }
    }
    float zz[8][2];
#pragma unroll
    for (int tk = 0; tk < 8; ++tk) { zz[tk][0] = 0.f; zz[tk][1] = 0.f; }
    {
        { const unsigned char* b0 = U8 + (size_t)j * SLICE; T_IDS(0);
#pragma unroll
          for (int it = 0; it < 16; ++it) T_LOAD(b0, it); }
        for (int s = 0; s < 8; ++s) {
            const int sl = (j + s) & 7, sln = (sl + 1) & 7;
            const unsigned char* bcur = U8 + (size_t)sl * SLICE; const unsigned char* bnxt = U8 + (size_t)sln * SLICE;
#define U_STEP(tk) do { constexpr int tn = ((tk) + 1) & 7; const unsigned char* nb = ((tk) == 7) ? bnxt : bcur; \
            T_IDS(tn); \
            const v4u hb = *(const LAS v4u*)(hq + (tk) * 1024 + 128 * sl + 16 * cg);        \
            int part[16];                                                                     \
            _Pragma("unroll") for (int it = 0; it < 16; ++it) { \
                asm volatile("" : "+v"(buf[it])); \
                int a0 = __builtin_amdgcn_sdot4((int)buf[it][0], (int)hb[0], 0, false); a0 = __builtin_amdgcn_sdot4((int)buf[it][1], (int)hb[1], a0, false); \
                a0 = __builtin_amdgcn_sdot4((int)buf[it][2], (int)hb[2], a0, false); a0 = __builtin_amdgcn_sdot4((int)buf[it][3], (int)hb[3], a0, false); \
                part[it] = a0; asm volatile("" : "+v"(part[it])); \
                T_LOAD(nb, it); } \
            int p8[8], p4[4], p2[2]; \
            { const bool up = (lane & 4) != 0; _Pragma("unroll") for (int e = 0; e < 8; ++e) { const int snd = up ? part[e] : part[e + 8], kp = up ? part[e + 8] : part[e]; p8[e] = kp + DPP_I(snd, DPP_HALF_MIRROR); } }     \
            { const bool up = (lane & 2) != 0; _Pragma("unroll") for (int e = 0; e < 4; ++e) { const int snd = up ? p8[e] : p8[e + 4], kp = up ? p8[e + 4] : p8[e]; p4[e] = kp + DPP_I(snd, DPP_XOR2); } } \
            { const bool up = (lane & 1) != 0; _Pragma("unroll") for (int e = 0; e < 2; ++e) { const int snd = up ? p4[e] : p4[e + 2], kp = up ? p4[e + 2] : p4[e]; p2[e] = kp + DPP_I(snd, DPP_XOR1); } } \
            zz[tk][0] += (float)p2[0]; zz[tk][1] += (float)p2[1];                            \
            } while (0)
            U_STEP(0); U_STEP(1); U_STEP(2); U_STEP(3); U_STEP(4); U_STEP(5); U_STEP(6); U_STEP(7);
#undef U_STEP
        }
    }
    {
        const float* SU = (const float*)(F.ws + WS_SU); const float* SV = (const float*)(F.ws + WS_SV);
#pragma unroll
        for (int tk = 0; tk < 8; ++tk) {
            const float* ssp = (const float*)(F.ws + WS_SS) + (size_t)(tok0 + tk) * 16; float ss = 0.f;
#pragma unroll
            for (int q = 0; q < 4; ++q) { const f32x4 v = *(const GAS f32x4*)(ssp + 4 * q); ss += (v.x + v.y) + (v.z + v.w); }
            const float r2 = 1.f / sqrtf(ss * (1.f / D) + NORM_EPS);
#pragma unroll
            for (int e = 0; e < 2; ++e) { const int slot = (2 * cg + e) * 8 + sg;
                const int ida = __shfl(i0[tk], slot & 63), idb = __shfl(i1[tk], slot & 63); const int id = cg < 4 ? ida : idb;
                const float g = ((const float*)(F.ws + WS_G))[(size_t)(tok0 + tk) * 128 + slot];
                zz[tk][e] = g * gelu_exact(r2 * sh[tk] * SU[id] * zz[tk][e]) * SV[id]; }
        }
    }
    float ssq[8];
    LAS v4u* cqL = (LAS v4u*)(F.lds + RING_OFF + 65536 + F.wave * 8192); float scv[8];
#pragma unroll
    for (int tk = 0; tk < 8; ++tk) {
        float am = fmaxf(fabsf(zz[tk][0]), fabsf(zz[tk][1]));
#pragma unroll
        for (int o = 1; o < 64; o <<= 1) am = fmaxf(am, __shfl_xor(am, o));
        const float sc = am > 0.f ? am * (1.f / 127.f) : 1.f, inv = 1.f / sc;
        scv[tk] = sc;
        const int q0 = __float2int_rn(zz[tk][0] * inv) & 255, q1 = __float2int_rn(zz[tk][1] * inv) & 255;
        v4u wq;
#pragma unroll
        for (int g = 0; g < 4; ++g) { unsigned w = 0u;
#pragma unroll
            for (int b = 0; b < 4; ++b) { const int it = 4 * g + b; w |= (unsigned)__shfl((it & 1) ? q1 : q0, sg * 8 + (it >> 1)) << (8 * b); }
            wq[g] = w; }
        cqL[tk * 64 + lane] = wq;
    }
    for (int vrep_ = 0; vrep_ < ((REP_PHASE == 31) ? 3 : 1); ++vrep_)
    {
#pragma unroll
    for (int tk = 0; tk < 8; ++tk) ssq[tk] = 0.f;
        float* XO = F.out + (size_t)tok0 * D + 16 * cg + 2 * sg;
        const unsigned char* XB = F.ws + WS_A8 + (size_t)tok0 * D + 16 * cg + 2 * sg;
        unsigned xC, xN;
        xC = *(const GAS unsigned short*)(XB + 128 * j);
        { const unsigned char* b0 = V8 + (size_t)j * SLICE; T_IDS(0);
#pragma unroll
          for (int it = 0; it < 16; ++it) T_LOAD(b0, it); }
        for (int s = 0; s < 8; ++s) {
            const int sl = (j + s) & 7, sln = (sl + 1) & 7;
            const unsigned char* bcur = V8 + (size_t)sl * SLICE; const unsigned char* bnxt = V8 + (size_t)sln * SLICE;
#define V_STEP(tk) do { constexpr int tn = ((tk) + 1) & 7; const int slq = ((tk) == 7) ? sln : sl; const unsigned char* nb = ((tk) == 7) ? bnxt : bcur; \
            T_IDS(tn); \
            xN = *(const GAS unsigned short*)(XB + (size_t)tn * D + 128 * slq); \
            const v4u cqv = cqL[(tk) * 64 + lane]; \
            int ai[16]; \
            _Pragma("unroll") for (int e = 0; e < 16; ++e) ai[e] = 0; \
            _Pragma("unroll") for (int g = 0; g < 4; ++g) { \
                asm volatile("" : "+v"(buf[4 * g]), "+v"(buf[4 * g + 1]), "+v"(buf[4 * g + 2]), "+v"(buf[4 * g + 3])); \
                const int cq_ = (int)cqv[g]; \
                _Pragma("unroll") for (int z = 0; z < 4; ++z) { const unsigned R0 = buf[4 * g][z], R1 = buf[4 * g + 1][z], R2 = buf[4 * g + 2][z], R3 = buf[4 * g + 3][z]; \
                    const unsigned l01 = __builtin_amdgcn_perm(R1, R0, 0x05010400u), h01 = __builtin_amdgcn_perm(R1, R0, 0x07030602u), l23 = __builtin_amdgcn_perm(R3, R2, 0x05010400u), h23 = __builtin_amdgcn_perm(R3, R2, 0x07030602u); \
                    ai[4 * z]     = __builtin_amdgcn_sdot4((int)__builtin_amdgcn_perm(l23, l01, 0x05040100u), cq_, ai[4 * z], false); \
                    ai[4 * z + 1] = __builtin_amdgcn_sdot4((int)__builtin_amdgcn_perm(l23, l01, 0x07060302u), cq_, ai[4 * z + 1], false); \
                    ai[4 * z + 2] = __builtin_amdgcn_sdot4((int)__builtin_amdgcn_perm(h23, h01, 0x05040100u), cq_, ai[4 * z + 2], false); \
                    ai[4 * z + 3] = __builtin_amdgcn_sdot4((int)__builtin_amdgcn_perm(h23, h01, 0x07060302u), cq_, ai[4 * z + 3], false); } \
                asm volatile("" : "+v"(ai[0]), "+v"(ai[1]), "+v"(ai[2]), "+v"(ai[3]), "+v"(ai[4]), "+v"(ai[5]), "+v"(ai[6]), "+v"(ai[7])); \
                asm volatile("" : "+v"(ai[8]), "+v"(ai[9]), "+v"(ai[10]), "+v"(ai[11]), "+v"(ai[12]), "+v"(ai[13]), "+v"(ai[14]), "+v"(ai[15])); \
                T_LOAD(nb, 4 * g); T_LOAD(nb, 4 * g + 1); T_LOAD(nb, 4 * g + 2); T_LOAD(nb, 4 * g + 3); } \
            int r8[8], r4[4], r2[2];                                                         \
            _Pragma("unroll") for (int e = 0; e < 8; ++e) { const auto w_ = __builtin_amdgcn_permlane32_swap((unsigned)ai[e], (unsigned)ai[e + 8], false, false); r8[e] = (int)(w_[0] + w_[1]); } \
            _Pragma("unroll") for (int e = 0; e < 4; ++e) { const auto w_ = __builtin_amdgcn_permlane16_swap((unsigned)r8[e], (unsigned)r8[e + 4], false, false); r4[e] = (int)(w_[0] + w_[1]); } \
            { const bool up = (lane & 8) != 0; _Pragma("unroll") for (int e = 0; e < 2; ++e) { const int snd = up ? r4[e] : r4[e + 2], kp = up ? r4[e + 2] : r4[e]; r2[e] = kp + DPP_I(snd, DPP_ROR8); } } \
            const unsigned xb_ = xC ^ 0x8080u;                                                \
            f32x2p x_ = {((float)(xb_ & 0xffu) - 128.f) * sh[tk] + (float)r2[0] * scv[tk], ((float)((xb_ >> 8) & 0xffu) - 128.f) * sh[tk] + (float)r2[1] * scv[tk]}; \
            *(GAS f32x2p*)(XO + (size_t)(tk) * D + 128 * sl) = x_; \
            ssq[tk] += x_.x * x_.x + x_.y * x_.y; \
            xC = xN; } while (0)
            V_STEP(0); V_STEP(1); V_STEP(2); V_STEP(3); V_STEP(4); V_STEP(5); V_STEP(6); V_STEP(7);
#undef V_STEP
        }
    }
#undef T_LOAD
#undef T_IDS
    asm volatile("s_waitcnt vmcnt(0)" ::: "memory");
    {
        const GAS f32x4* wr = (const GAS f32x4*)args.in[19] + lane;
#pragma unroll
        for (int tk = 0; tk < 8; ++tk) {
            const float rf = 1.f / sqrtf(wave_sum(ssq[tk]) * (1.f / D) + NORM_EPS);
            GAS f32x4* xr = (GAS f32x4*)(F.out + (size_t)(tok0 + tk) * D) + lane;
#pragma unroll
            for (int q = 0; q < 4; ++q) { const f32x4 v = __builtin_nontemporal_load(xr + 64 * q); const f32x4 g = wr[64 * q]; xr[64 * q] = (f32x4){v.x * rf * g.x, v.y * rf * g.y, v.z * rf * g.z, v.w * rf * g.w}; }
        }
    }
}

__global__ void __launch_bounds__(NWAVES * 64, 2) hymba_fwd(Args args) {
    extern __shared__ __attribute__((aligned(16))) unsigned char lds[];
#if USE_CG_SYNC
    cg::grid_group grid = cg::this_grid();
#endif
    Frame F;
    F.lds = (LAS unsigned char*)lds;
    frame_refresh(F);
    F.G = gridDim.x; { const int bx = blockIdx.x; F.vcu = (F.G % 8 == 0) ? (bx % 8) * (F.G / 8) + bx / 8 : bx; }
    F.out = args.out; F.ws = args.ws;
    unsigned char* ws = args.ws;
#if USE_CG_SYNC
#define GRID_SYNC() grid.sync()
#else
    for (int u = F.tid; u < (LDS_BYTES - LDSCTL_OFF) / 4; u += NWAVES * 64) ((LAS unsigned*)(F.lds + LDSCTL_OFF))[u] = 0u;
    __syncthreads();
    const XcdBarrier bar = xcd_barrier_post((unsigned*)(ws + WS_CTL) + CW_BAR, (volatile LAS unsigned*)(F.lds + MISC_OFF) + 8);
#define GRID_SYNC() xcd_barrier(bar)
#endif

    for (int rep_ = 0; rep_ < NREP(10); ++rep_) { p0_prologue(F, args); GRID_SYNC(); }

    {
        pg8::Gemm g{(const pg8::bf16_t*)(ws + WS_XN), (const pg8::bf16_t*)(ws + WS_WIN), M, NIN, D / 2};
        pg8::StaticOrder S; S.init(M, NIN, F.G, (int)blockIdx.x);
        pg8::EpiInProj E{(pg8::bf16_t*)(ws + WS_Q), (pg8::bf16_t*)(ws + WS_K), (const float*)(ws + WS_ROPE), attn_body::C2, (float*)(ws + WS_LNS), (const float*)(ws + WS_SA), (const float*)(ws + WS_SB)};
        static_assert(WS_V == WS_K + 16 * MiB && WS_U == WS_V + 16 * MiB && WS_VG == WS_U + 16 * MiB, "K|V|U|VG contiguous");
        for (int rep_ = 0; rep_ < NREP(11); ++rep_) { pg8::gemm_phase<pg8::EpiInProj, pg8::StaticOrder, true, true, true>(F.lds + RING_OFF, g, S, E);
            if (blockIdx.x >= 128) { frame_refresh(F); const float* fw = args.in[14] + 16 * F.lane; const f32x4 fw4[4] = {*(const GAS f32x4*)fw, *(const GAS f32x4*)(fw + 4), *(const GAS f32x4*)(fw + 8), *(const GAS f32x4*)(fw + 12)};
                for (int r = ((int)blockIdx.x - 128) * NWAVES + F.wave; r < NEXP; r += 128 * NWAVES) int8_table_row(F, args, r, fw4); }
            GRID_SYNC(); }
    }

    frame_refresh(F);
    {
        for (int rep_ = 0; rep_ < NREP(12); ++rep_) for (int it = F.vcu; it < 256; it += F.G) sgu_item(F, args, it >> 1, it & 1);
        float s1 = 0.f, s2 = 0.f;
#pragma unroll 4
        for (int i = 0; i < 32; ++i) { s1 += args.in[3][i] * args.in[4][i]; s2 += args.in[5][i] * args.in[6][i]; }
        const float lam = __uint_as_float(__builtin_amdgcn_readfirstlane(__float_as_uint(expf(s1) - expf(s2) + 0.2f)));
        const attn_body::AttnTensors AT{(const attn_body::bf16*)(ws + WS_Q), (const attn_body::bf16*)(ws + WS_K), (const attn_body::bf16*)(ws + WS_V), (attn_body::bf16*)(ws + WS_MIX)};
        const attn_body::StaticOrder S((int)F.G, (int)blockIdx.x);
        for (int rep_ = 0; rep_ < NREP(13); ++rep_) attn_body::attn_phase<attn_body::StaticOrder>((char*)lds + RING_OFF, AT, S, lam, args.in[7]);
    }
    GRID_SYNC();

    {
        pg8::Gemm g{(const pg8::bf16_t*)(ws + WS_MIX), (const pg8::bf16_t*)(ws + WS_WO), M, D, D};
        pg8::StaticOrder S; S.init(M, D, F.G, (int)blockIdx.x);
        pg8::EpiOutProj E{args.in[0], F.out, (pg8::bf16_t*)(ws + WS_X1B), (float*)(ws + WS_SS), (unsigned*)(ws + WS_PM), (LAS float*)(F.lds + RING_BYTES), ws + WS_A8, (float*)(ws + WS_SA2)};
        for (int rep_ = 0; rep_ < NREP(14); ++rep_) { pg8::gemm_phase<pg8::EpiOutProj, pg8::StaticOrder, true, true>(F.lds + RING_OFF, g, S, E); GRID_SYNC(); }
    }

#if STAGE >= 9
    {
        pg8::Gemm g{(const pg8::bf16_t*)(ws + WS_A8), (const pg8::bf16_t*)(ws + WS_WQ), M, NQP, D / 2};
        pg8::StaticOrder S; S.init(M, NQP, F.G, (int)blockIdx.x);
        pg8::EpiDq8 E{(pg8::bf16_t*)(ws + WS_QP), NQP, (const float*)(ws + WS_SA2), (const float*)(ws + WS_SBQ)};
        for (int rep_ = 0; rep_ < NREP(15); ++rep_) { pg8::gemm_phase<pg8::EpiDq8, pg8::StaticOrder, true, true, true>(F.lds + RING_OFF, g, S, E); GRID_SYNC(); }
    }

    frame_refresh(F);
    for (int rep_ = 0; rep_ < NREP(16); ++rep_) { p5_unit(F, (int)(blockIdx.x & 7) * 2048 + (int)(blockIdx.x >> 3) * 64); asm volatile("s_waitcnt vmcnt(0)" ::: "memory"); __syncthreads(); }
#endif

    frame_refresh(F);
    p6_tail(F, args);
}

extern "C" void kernel_launch(void* const* d_in, const int* in_sizes, int n_in, void* d_out, int out_size, void* d_ws, size_t ws_size, hipStream_t stream) {
    static int grid = 0;
    if (grid == 0) {
        if (n_in != 20 || in_sizes[0] != M * D || out_size != M * D || ws_size < WS_END) { fprintf(stderr, "kernel_launch: unexpected shapes (n_in %d, in0 %d, out %d, ws %zu)\n", n_in, n_in > 0 ? in_sizes[0] : -1, out_size, ws_size); grid = -1; return; }
        int dev = 0, cus = 0, per_cu = 0;
        if (hipGetDevice(&dev) != hipSuccess || hipDeviceGetAttribute(&cus, hipDeviceAttributeMultiprocessorCount, dev) != hipSuccess) { grid = -1; return; }
        if (hipFuncSetAttribute((const void*)hymba_fwd, hipFuncAttributeMaxDynamicSharedMemorySize, LDS_BYTES) != hipSuccess) { fprintf(stderr, "kernel_launch: hipFuncSetAttribute failed\n"); grid = -1; return; }
        if (hipOccupancyMaxActiveBlocksPerMultiprocessor(&per_cu, (const void*)hymba_fwd, NWAVES * 64, LDS_BYTES) != hipSuccess || per_cu < 1) { fprintf(stderr, "kernel_launch: occupancy query says %d blocks per CU\n", per_cu); per_cu = 1; }
        (void)hipGetLastError();
        grid = cus;
        if (grid != 256) { fprintf(stderr, "kernel_launch: this kernel's PEER phases need a 256-workgroup grid (256 CUs); device has %d\n", cus); grid = -1; return; }
    }
    if (grid < 0) return;
    Args a{};
    for (int i = 0; i < 20; ++i) a.in[i] = (const float*)d_in[i];
    a.out = (float*)d_out; a.ws = (unsigned char*)d_ws;
#if USE_CG_SYNC
    void* kargs[] = {&a};
    const hipError_t e = hipLaunchCooperativeKernel((const void*)hymba_fwd, dim3(grid), dim3(NWAVES * 64), kargs, LDS_BYTES, stream);
    if (e != hipSuccess) fprintf(stderr, "kernel_launch: cooperative launch failed: %s (grid %d)\n", hipGetErrorString(e), grid);
#else
    if (hipMemsetAsync((char*)d_ws + WS_CTL, 0, 65536, stream) != hipSuccess) { fprintf(stderr, "kernel_launch: hipMemsetAsync failed\n"); return; }
    hipLaunchKernelGGL(hymba_fwd, dim3(grid), dim3(NWAVES * 64), LDS_BYTES, stream, a);
    const hipError_t e = hipPeekAtLastError();
    if (e != hipSuccess) fprintf(stderr, "kernel_launch: launch failed: %s (grid %d)\n", hipGetErrorName(e), grid);
#endif
}
```

```cpp
#include <hip/hip_runtime.h>
#include <hip/hip_cooperative_groups.h>
#include <cstdio>
#include <cstdint>
namespace cg = cooperative_groups;
namespace pg8 {
#define PG8_LAS __attribute__((address_space(3)))
typedef unsigned short bf16_t;
typedef short bf16x8 __attribute__((ext_vector_type(8)));
typedef float f32x4 __attribute__((ext_vector_type(4)));
typedef unsigned u32x4 __attribute__((ext_vector_type(4)));
typedef int i32x4 __attribute__((ext_vector_type(4)));
template <bool I8> struct AccSel { typedef f32x4 T; };
template <> struct AccSel<true> { typedef i32x4 T; };
constexpr int BM = 256, BK = 64, HALF = 128, HTB = HALF * BK * 2  , STAGE_BYTES = 8 * HTB, NXCD = 8, WGM = 8;

__host__ __device__ __forceinline__ int lds_byte(int r, int c) { const int st = (r >> 4) * 2 + (c >> 5), rr = r & 15, cc = c & 31, ob = rr * 64 + cc * 2; return st * 1024 + (ob ^ (((ob >> 9) & 1) << 5)); }
__host__ __device__ __forceinline__ void stage_rc(int b, int& R, int& C) { const int st = b / 1024, sb = b % 1024, swz = sb ^ (((sb >> 9) & 1) << 5); R = (st >> 1) * 16 + swz / 64; C = (st & 1) * 32 + (swz % 64) / 2; }
__host__ __device__ __forceinline__ int perm32(int rho) { const int n = rho >> 4, i = rho & 15; return 8 * (i >> 2) + 4 * n + (i & 3); }

struct Unit { int pm, pn; };
struct Gemm { const bf16_t* A; const bf16_t* Bt; int M, N, K; };

struct StaticOrder {
    int nM, nN, nwg, G, c;
    __host__ __device__ void init(int M, int N, int G_, int c_) { nM = M / BM; nN = N / BM; nwg = nM * nN; G = G_; c = c_; }
    __host__ __device__ bool next(int i, Unit& u) const {
        const long L = (long)i * G + c; if (L >= nwg) return false;
        int wgid = (int)L; { const int q = nwg / NXCD, r = nwg % NXCD, xcd = wgid % NXCD, off = wgid / NXCD; wgid = (xcd < r ? xcd * (q + 1) : r * (q + 1) + (xcd - r) * q) + off; }
        const int nig = WGM * nN, gid = wgid / nig, fm = gid * WGM, gsz = (nM - fm) < WGM ? (nM - fm) : WGM;
        u.pm = fm + ((wgid % nig) % gsz); u.pn = (wgid % nig) / gsz; return true;
    }
    __device__ __forceinline__ void a_ready(const Unit&) const {}
    __device__ __forceinline__ void done(const Unit&) const {}
};

__device__ __forceinline__ unsigned cvt_pk_bf16(float lo, float hi) { unsigned r; asm volatile("v_cvt_pk_bf16_f32 %0, %1, %2" : "=v"(r) : "v"(lo), "v"(hi)); return r; }
typedef float f32x2 __attribute__((ext_vector_type(2)));
__device__ __forceinline__ f32x2 gelu_pk(f32x2 v) {
    const f32x2 a = __builtin_elementwise_abs(v);
    f32x2 q = a * (-1.8350689288126887e-06f) + 6.160390330478549e-05f; q = q * a + (-0.0009305728599429131f); q = q * a + 0.008508095517754555f; q = q * a + (-0.05396052449941635f);
    q = q * a + (-0.4584639072418213f); q = q * a + (-1.1512513160705566f); q = q * a + (-0.9999952912330627f);
    f32x2 e; e.x = __builtin_amdgcn_exp2f(q.x); e.y = __builtin_amdgcn_exp2f(q.y);
    const f32x2 m = v * e, r = v - m;
    f32x2 o; o.x = v.x < 0.f ? m.x : r.x; o.y = v.y < 0.f ? m.y : r.y; return o;
}

template <int ACT  > struct EpiBf16 {
    static constexpr bool PERM = true, AFTER_DRAIN = false; static_assert(ACT == 0 || ACT == 1, "EpiBf16: ACT is 0 (none) or 1 (gelu_pk)");
    bf16_t* O; int ldc; const float* bias; int split_cols; size_t split_stride; float scale0;
    __device__ __forceinline__ void operator()(const f32x4 (&acc)[2][2][4][2], const Unit& u, int wr, int wc, int fr, int fq) const {
        const int row0 = u.pm * BM + wr * 64 + fr; int colt = u.pn * BM; bf16_t* base = O;
        float sc = 1.f; if (split_cols) { const int t = colt / split_cols; base += (size_t)t * split_stride; colt -= t * split_cols; if (t == 0) sc = scale0; }
        const int col0 = colt + wc * 32 + 8 * fq, bcol0 = u.pn * BM + wc * 32 + 8 * fq;
        f32x4 bv[2][2];
#pragma unroll
        for (int bj = 0; bj < 2; ++bj)
#pragma unroll
            for (int n = 0; n < 2; ++n) bv[bj][n] = bias ? *(const f32x4*)(bias + bcol0 + bj * HALF + 4 * n) : (f32x4){0.f, 0.f, 0.f, 0.f};
#pragma unroll
        for (int ai = 0; ai < 2; ++ai)
#pragma unroll
            for (int m = 0; m < 4; ++m) { bf16_t* rowp = base + (size_t)(row0 + ai * HALF + m * 16) * ldc + col0;
#pragma unroll
                for (int bj = 0; bj < 2; ++bj) { f32x4 v0 = acc[ai][bj][m][0] + bv[bj][0], v1 = acc[ai][bj][m][1] + bv[bj][1];
                    if (ACT == 1) { f32x2 a = gelu_pk((f32x2){v0[0], v0[1]}), b = gelu_pk((f32x2){v0[2], v0[3]}), c = gelu_pk((f32x2){v1[0], v1[1]}), d = gelu_pk((f32x2){v1[2], v1[3]});
                        v0 = (f32x4){a.x, a.y, b.x, b.y}; v1 = (f32x4){c.x, c.y, d.x, d.y}; }
                    v0 = v0 * sc; v1 = v1 * sc; u32x4 w; w.x = cvt_pk_bf16(v0[0], v0[1]); w.y = cvt_pk_bf16(v0[2], v0[3]); w.z = cvt_pk_bf16(v1[0], v1[1]); w.w = cvt_pk_bf16(v1[2], v1[3]);
                    *(u32x4*)(rowp + bj * HALF) = w; } }
    }
};
__device__ __forceinline__ void st_wt16(void* p, u32x4 v) { asm volatile("global_store_dwordx4 %0, %1, off sc1\n\ts_nop 2" :: "v"(p), "v"(v) : "memory"); }
__device__ __forceinline__ unsigned pk4_i8(float a, float b, float c, float d) {
    const int qa = __float2int_rn(a), qb = __float2int_rn(b), qc = __float2int_rn(c), qd = __float2int_rn(d);
    return (unsigned)(qa & 255) | ((unsigned)(qb & 255) << 8) | ((unsigned)(qc & 255) << 16) | ((unsigned)qd << 24);
}
typedef float f32x2e __attribute__((ext_vector_type(2)));
struct EpiInProj {
    static constexpr bool PERM = true, AFTER_DRAIN = false;
    bf16_t *Q, *K; const float* rope; float qscale; float* LNS; const float* SA; const float* SB;
    __device__ __forceinline__ void operator()(const i32x4 (&acc)[2][2][4][2], const Unit& u, int wr, int wc, int fr, int fq) const {
        const int row0 = u.pm * BM + wr * 64 + fr;
        const int sect = u.pn >> 1;
        float sa[2][4]; f32x4 sb[2][2];
#pragma unroll
        for (int ai = 0; ai < 2; ++ai)
#pragma unroll
            for (int m = 0; m < 4; ++m) sa[ai][m] = SA[row0 + ai * HALF + m * 16];
#pragma unroll
        for (int bj = 0; bj < 2; ++bj) { const f32x4* sp = (const f32x4*)(SB + u.pn * BM + bj * HALF + wc * 32 + 8 * fq); sb[bj][0] = sp[0]; sb[bj][1] = sp[1]; }
        f32x4 af[2][2][4][2];
#pragma unroll
        for (int ai = 0; ai < 2; ++ai)
#pragma unroll
            for (int bj = 0; bj < 2; ++bj)
#pragma unroll
                for (int m = 0; m < 4; ++m)
#pragma unroll
                    for (int n = 0; n < 2; ++n) af[ai][bj][m][n] = __builtin_convertvector(acc[ai][bj][m][n], f32x4) * sa[ai][m] * sb[bj][n];
#define DQ(ai, bj, m, n) af[ai][bj][m][n]
        const int colt = (u.pn & 1) * 256;
        if (sect <= 1) {
            const bool hiH = fq >= 2;
            bf16_t* dstb = (sect == 0) ? Q : K; const float qs = (sect == 0) ? qscale : 1.f;
#define ROPE2(oA, oB, A, B, C_, S_) { const auto r_ = __builtin_amdgcn_permlane32_swap(__float_as_uint(A), __float_as_uint(B), false, false); \
            const float x_ = __uint_as_float(r_[0]), y_ = __uint_as_float(r_[1]); const float o1_ = x_ * (C_) - y_ * (S_), o2_ = y_ * (C_) + x_ * (S_); \
            const auto q_ = __builtin_amdgcn_permlane32_swap(__float_as_uint(o1_), __float_as_uint(o2_), false, false); oA = __uint_as_float(q_[0]) * qs; oB = __uint_as_float(q_[1]) * qs; }
#pragma unroll
            for (int ai = 0; ai < 2; ++ai) {
                f32x4 cs[4][4];
#pragma unroll
                for (int m = 0; m < 4; ++m) { const int pos = (row0 + ai * HALF + m * 16) & 4095; const f32x4* rp = (const f32x4*)(rope + (size_t)pos * 32 + (fq & 1) * 16);
                    cs[m][0] = rp[0]; cs[m][1] = rp[1]; cs[m][2] = rp[2]; cs[m][3] = rp[3]; }
#pragma unroll
                for (int m = 0; m < 4; ++m) {
                    const int row = row0 + ai * HALF + m * 16;
                    float C[4], S[4];
#pragma unroll
                    for (int p = 0; p < 4; ++p) { C[p] = hiH ? cs[m][p][2] : cs[m][p][0]; S[p] = hiH ? cs[m][p][3] : cs[m][p][1]; }
#pragma unroll
                    for (int bj = 0; bj < 2; ++bj) {
                        const f32x4 va = DQ(ai, bj, m, 0), vb = DQ(ai, bj, m, 1);
                        float o[8];
                        ROPE2(o[0], o[1], va[0], va[1], C[0], S[0]) ROPE2(o[2], o[3], va[2], va[3], C[1], S[1]) ROPE2(o[4], o[5], vb[0], vb[1], C[2], S[2]) ROPE2(o[6], o[7], vb[2], vb[3], C[3], S[3])
                        const int cl = colt + bj * HALF + wc * 32;
                        u32x4 w; w.x = cvt_pk_bf16(o[0], o[1]); w.y = cvt_pk_bf16(o[2], o[3]); w.z = cvt_pk_bf16(o[4], o[5]); w.w = cvt_pk_bf16(o[6], o[7]);
                        *(u32x4*)(dstb + (size_t)row * 512 + cl + 8 * fq) = w;
                    }
                }
            }
#undef ROPE2
        } else {
            bf16_t* base = K + (size_t)(sect - 1) * ((size_t)16384 * 512);
#pragma unroll
            for (int ai = 0; ai < 2; ++ai)
#pragma unroll
                for (int m = 0; m < 4; ++m) {
                    bf16_t* rowp = base + (size_t)(row0 + ai * HALF + m * 16) * 512 + colt + wc * 32 + 8 * fq;
                    float s1 = 0.f, s2 = 0.f;
#pragma unroll
                    for (int bj = 0; bj < 2; ++bj) {
                        f32x4 v0 = DQ(ai, bj, m, 0), v1 = DQ(ai, bj, m, 1);
                        if (sect >= 3) { f32x2 a = gelu_pk((f32x2){v0[0], v0[1]}), b = gelu_pk((f32x2){v0[2], v0[3]}), c = gelu_pk((f32x2){v1[0], v1[1]}), d = gelu_pk((f32x2){v1[2], v1[3]});
                            v0 = (f32x4){a.x, a.y, b.x, b.y}; v1 = (f32x4){c.x, c.y, d.x, d.y}; }
                        u32x4 w; w.x = cvt_pk_bf16(v0[0], v0[1]); w.y = cvt_pk_bf16(v0[2], v0[3]); w.z = cvt_pk_bf16(v1[0], v1[1]); w.w = cvt_pk_bf16(v1[2], v1[3]);
                        *(u32x4*)(rowp + bj * HALF) = w;
                        if (sect == 4) { s1 += ((v0[0] + v0[1]) + (v0[2] + v0[3])) + ((v1[0] + v1[1]) + (v1[2] + v1[3]));
                            s2 += ((v0[0] * v0[0] + v0[1] * v0[1]) + (v0[2] * v0[2] + v0[3] * v0[3])) + ((v1[0] * v1[0] + v1[1] * v1[1]) + (v1[2] * v1[2] + v1[3] * v1[3])); }
                    }
                    if (sect == 4) { s1 += __shfl_xor(s1, 16); s1 += __shfl_xor(s1, 32); s2 += __shfl_xor(s2, 16); s2 += __shfl_xor(s2, 32);
                        if (fq == 0) *(f32x2e*)(LNS + ((size_t)(row0 + ai * HALF + m * 16) * 8 + (u.pn & 1) * 4 + wc) * 2) = (f32x2e){s1, s2}; }
                }
        }
#undef DQ
    }
};
struct EpiOutProj {
    static constexpr bool PERM = true, AFTER_DRAIN = false;
    const float* X; float* X1; bf16_t* X1b; float* SS; unsigned* PM; PG8_LAS float* L; unsigned char* A8; float* SA2;
    __device__ __forceinline__ void operator()(const f32x4 (&acc)[2][2][4][2], const Unit& u, int wr, int wc, int fr, int fq) const {
        const int row0 = u.pm * BM + wr * 64 + fr, col0 = u.pn * BM + wc * 32 + 8 * fq, rl0 = wr * 64 + fr;
        PG8_LAS float* LM = L; PG8_LAS float* FM = L + 1024;
        f32x4 v[2][4][2][2];
#pragma unroll
        for (int ai = 0; ai < 2; ++ai)
#pragma unroll
            for (int m = 0; m < 4; ++m) {
                const int row = row0 + ai * HALF + m * 16; float s = 0.f, am = 0.f;
#pragma unroll
                for (int bj = 0; bj < 2; ++bj) {
                    const size_t off = (size_t)row * 1024 + col0 + bj * HALF;
                    const f32x4 v0 = acc[ai][bj][m][0] + *(const f32x4*)(X + off), v1 = acc[ai][bj][m][1] + *(const f32x4*)(X + off + 4);
                    v[ai][m][bj][0] = v0; v[ai][m][bj][1] = v1;
                    s += (v0[0] * v0[0] + v0[1] * v0[1]) + (v0[2] * v0[2] + v0[3] * v0[3]) + (v1[0] * v1[0] + v1[1] * v1[1]) + (v1[2] * v1[2] + v1[3] * v1[3]);
                    am = fmaxf(am, fmaxf(fmaxf(fmaxf(fabsf(v0[0]), fabsf(v0[1])), fmaxf(fabsf(v0[2]), fabsf(v0[3]))), fmaxf(fmaxf(fabsf(v1[0]), fabsf(v1[1])), fmaxf(fabsf(v1[2]), fabsf(v1[3])))));
                }
                s += __shfl_xor(s, 16); s += __shfl_xor(s, 32); am = fmaxf(am, __shfl_xor(am, 16)); am = fmaxf(am, __shfl_xor(am, 32));
                if (fq == 0) { SS[(size_t)row * 16 + u.pn * 4 + wc] = s; LM[(rl0 + ai * HALF + m * 16) * 4 + wc] = am; }
            }
        __syncthreads();
        if (threadIdx.x < 256) {
            const int t = threadIdx.x; const f32x4 l = *(const PG8_LAS f32x4*)(LM + 4 * t);
            const float mine = fmaxf(fmaxf(l[0], l[1]), fmaxf(l[2], l[3]));
            unsigned* slot = PM + (size_t)(u.pm * BM + t) * 4;
            __hip_atomic_store(slot + u.pn, __float_as_uint(mine) | 0x80000000u, __ATOMIC_RELAXED, __HIP_MEMORY_SCOPE_AGENT);
            unsigned a0, a1, a2, a3, sp = 0;
            for (;;) { a0 = __hip_atomic_load(slot + 0, __ATOMIC_RELAXED, __HIP_MEMORY_SCOPE_AGENT); a1 = __hip_atomic_load(slot + 1, __ATOMIC_RELAXED, __HIP_MEMORY_SCOPE_AGENT);
                a2 = __hip_atomic_load(slot + 2, __ATOMIC_RELAXED, __HIP_MEMORY_SCOPE_AGENT); a3 = __hip_atomic_load(slot + 3, __ATOMIC_RELAXED, __HIP_MEMORY_SCOPE_AGENT);
                if (((a0 & a1 & a2 & a3) >> 31) != 0u || ++sp > (1u << 20)) break; __builtin_amdgcn_s_sleep(1); }
            FM[t] = fmaxf(fmaxf(__uint_as_float(a0 & 0x7fffffffu), __uint_as_float(a1 & 0x7fffffffu)), fmaxf(__uint_as_float(a2 & 0x7fffffffu), __uint_as_float(a3 & 0x7fffffffu)));
        }
        __syncthreads();
#pragma unroll
        for (int ai = 0; ai < 2; ++ai)
#pragma unroll
            for (int m = 0; m < 4; ++m) {
                const int row = row0 + ai * HALF + m * 16;
                const float am = FM[rl0 + ai * HALF + m * 16];
                const float sc = am > 0.f ? am * (1.f / 127.f) : 1.f, inv = 1.f / sc;
#pragma unroll
                for (int bj = 0; bj < 2; ++bj) { const f32x4 v0 = v[ai][m][bj][0] * inv, v1 = v[ai][m][bj][1] * inv;
                    f32x2e q; q.x = __uint_as_float(pk4_i8(v0[0], v0[1], v0[2], v0[3])); q.y = __uint_as_float(pk4_i8(v1[0], v1[1], v1[2], v1[3]));
                    *(f32x2e*)(A8 + (size_t)row * 1024 + col0 + bj * HALF) = q; }
                if (u.pn == 0 && wc == 0 && fq == 0) SA2[row] = sc;
            }
    }
};
struct EpiDq8 {
    static constexpr bool PERM = true, AFTER_DRAIN = false;
    bf16_t* O; int ldc; const float* SA; const float* SB;
    __device__ __forceinline__ void operator()(const i32x4 (&acc)[2][2][4][2], const Unit& u, int wr, int wc, int fr, int fq) const {
        const int row0 = u.pm * BM + wr * 64 + fr, col0 = u.pn * BM + wc * 32 + 8 * fq;
        f32x4 sb[2][2];
#pragma unroll
        for (int bj = 0; bj < 2; ++bj) { const f32x4* sp = (const f32x4*)(SB + col0 + bj * HALF); sb[bj][0] = sp[0]; sb[bj][1] = sp[1]; }
#pragma unroll
        for (int ai = 0; ai < 2; ++ai)
#pragma unroll
            for (int m = 0; m < 4; ++m) { const int row = row0 + ai * HALF + m * 16; const float sa = SA[row];
#pragma unroll
                for (int bj = 0; bj < 2; ++bj) { const f32x4 v0 = __builtin_convertvector(acc[ai][bj][m][0], f32x4) * sa * sb[bj][0], v1 = __builtin_convertvector(acc[ai][bj][m][1], f32x4) * sa * sb[bj][1];
                    u32x4 w; w.x = cvt_pk_bf16(v0[0], v0[1]); w.y = cvt_pk_bf16(v0[2], v0[3]); w.z = cvt_pk_bf16(v1[0], v1[1]); w.w = cvt_pk_bf16(v1[2], v1[3]);
                    st_wt16(O + (size_t)row * ldc + col0 + bj * HALF, w); } }
    }
};

template <class Epi, class Sched, bool ALIGN_EPI = false, bool SP2 = false, bool I8 = false>
__device__ __forceinline__ void gemm_phase(PG8_LAS unsigned char* lds, const Gemm g, const Sched& S, const Epi& E) {
    int tid_ = threadIdx.x; asm volatile("" : "+v"(tid_));
    const int tid = tid_, wid = __builtin_amdgcn_readfirstlane(tid >> 6), lane = tid & 63, wr = wid >> 2, wc = wid & 3, fr = lane & 15, fq = lane >> 4;
    const int K = g.K, nt = K / BK;
    unsigned voffA[2], voffB[2];
#pragma unroll
    for (int i = 0; i < 2; ++i) { int R, C; stage_rc(tid * 16 + i * 8192, R, C); const int Rb = Epi::PERM ? ((R & ~31) + perm32(R & 31)) : R;
        voffA[i] = (unsigned)(R * K + C) * 2u; voffB[i] = (unsigned)(Rb * K + C) * 2u; }
    const size_t kstep = (size_t)(BK * 2);
    const size_t hstep = (size_t)HALF * K * 2;
    const size_t tstep = 2 * hstep;
    const unsigned ldsw = (unsigned)wid * 1024u;
    const int aoff = lds_byte(wr * 64 + fr, fq * 8), boff = lds_byte(wc * 32 + fr, fq * 8);
#define PG8_SA(b, h) (((b) * 2 + (h)) * HTB)
#define PG8_SB(b, h) ((4 + (b) * 2 + (h)) * HTB)
#define PG8_STAGE(bufoff, gbase, voff) do { _Pragma("unroll") for (int _i = 0; _i < 2; ++_i) \
        __builtin_amdgcn_global_load_lds((const unsigned*)((const char*)(gbase) + (voff)[_i]), (PG8_LAS unsigned*)(lds + (bufoff) + ldsw + _i * 8192), 16, 0, 0); } while (0)
#define PG8_LDA(dst, b, h) do { _Pragma("unroll") for (int m = 0; m < 4; ++m) _Pragma("unroll") for (int k = 0; k < 2; ++k) dst[m][k] = *(const PG8_LAS bf16x8*)(lds + PG8_SA(b, h) + aoff + m * 2048 + k * 1024); } while (0)
#define PG8_LDB(dst, b, h) do { _Pragma("unroll") for (int n = 0; n < 2; ++n) _Pragma("unroll") for (int k = 0; k < 2; ++k) dst[n][k] = *(const PG8_LAS bf16x8*)(lds + PG8_SB(b, h) + boff + n * 2048 + k * 1024); } while (0)
#define PG8_MMA(ai, bj, At, Bt) do { __builtin_amdgcn_s_setprio(1); _Pragma("unroll") for (int m = 0; m < 4; ++m) _Pragma("unroll") for (int n = 0; n < 2; ++n) _Pragma("unroll") for (int k = 0; k < 2; ++k) \
        { if constexpr (I8) acc[ai][bj][m][n] = __builtin_bit_cast(AccT, __builtin_amdgcn_mfma_i32_16x16x64_i8(__builtin_bit_cast(i32x4, Bt[n][k]), __builtin_bit_cast(i32x4, At[m][k]), __builtin_bit_cast(i32x4, acc[ai][bj][m][n]), 0, 0, 0)); \
          else acc[ai][bj][m][n] = __builtin_bit_cast(AccT, __builtin_amdgcn_mfma_f32_16x16x32_bf16(Bt[n][k], At[m][k], __builtin_bit_cast(f32x4, acc[ai][bj][m][n]), 0, 0, 0)); } __builtin_amdgcn_s_setprio(0); } while (0)
#define PG8_WAIT_V(n) asm volatile("s_waitcnt vmcnt(" #n ")" ::: "memory")
#define PG8_WAIT_L(n) asm volatile("s_waitcnt lgkmcnt(" #n ")" ::: "memory")
#define PG8_BAR __builtin_amdgcn_s_barrier()
#define PG8_SCHED __builtin_amdgcn_sched_barrier(0)
    Unit cur, nxt; int ui = 0;
    if (!S.next(0, cur)) return;
    typedef typename AccSel<I8>::T AccT;
    AccT acc[2][2][4][2];
#pragma unroll
    for (int a = 0; a < 2; ++a)
#pragma unroll
        for (int b = 0; b < 2; ++b)
#pragma unroll
            for (int m = 0; m < 4; ++m)
#pragma unroll
                for (int n = 0; n < 2; ++n) acc[a][b][m][n] = (AccT){0, 0, 0, 0};
    bf16x8 At[4][2], B0[2][2], B1[2][2];
    const char* cA = (const char*)g.A + (size_t)cur.pm * tstep; const char* cB = (const char*)g.Bt + (size_t)cur.pn * tstep;
    S.a_ready(cur);
    if constexpr (SP2) {
        PG8_STAGE(PG8_SB(0, 0), cB, voffB); PG8_STAGE(PG8_SB(0, 1), cB + hstep, voffB); PG8_STAGE(PG8_SA(0, 0), cA, voffA); PG8_STAGE(PG8_SA(0, 1), cA + hstep, voffA);
        if (wr == 1) PG8_BAR;
        PG8_WAIT_V(2); PG8_BAR;
        PG8_STAGE(PG8_SB(1, 0), cB + kstep, voffB); PG8_STAGE(PG8_SA(1, 0), cA + kstep, voffA); PG8_STAGE(PG8_SB(1, 1), cB + hstep + kstep, voffB);
        PG8_WAIT_V(6); PG8_BAR;
    } else {
        PG8_STAGE(PG8_SB(0, 0), cB, voffB); PG8_STAGE(PG8_SA(0, 0), cA, voffA); PG8_STAGE(PG8_SB(0, 1), cB + hstep, voffB); PG8_STAGE(PG8_SA(0, 1), cA + hstep, voffA);
        if (wr == 1) PG8_BAR;
        PG8_WAIT_V(4); PG8_BAR;
        PG8_STAGE(PG8_SB(1, 0), cB + kstep, voffB); PG8_STAGE(PG8_SA(1, 0), cA + kstep, voffA); PG8_STAGE(PG8_SB(1, 1), cB + hstep + kstep, voffB);
        PG8_WAIT_V(6); PG8_BAR;
    }
    for (;;) {
        const bool has_next = S.next(ui + 1, nxt);
        const char* nA = has_next ? (const char*)g.A + (size_t)nxt.pm * tstep : cA; const char* nB = has_next ? (const char*)g.Bt + (size_t)nxt.pn * tstep : cB;
        for (int t = 0; t < nt; t += 2) {
            const bool last = (t == nt - 2);
            const char* a1 = cA + (size_t)(t + 1) * kstep;
            const char* a2 = last ? nA : cA + (size_t)(t + 2) * kstep; const char* b2 = last ? nB : cB + (size_t)(t + 2) * kstep;
            const char* a3 = a2 + kstep; const char* b3 = b2 + kstep;
            if (last && has_next) S.a_ready(nxt);
            if constexpr (SP2) {
            PG8_LDB(B0, 0, 0); PG8_LDB(B1, 0, 1); PG8_SCHED; PG8_LDA(At, 0, 0); PG8_STAGE(PG8_SA(1, 1), a1 + hstep, voffA);
            PG8_WAIT_V(8); PG8_WAIT_L(0); PG8_BAR; PG8_MMA(0, 0, At, B0); PG8_MMA(0, 1, At, B1); PG8_BAR; PG8_SCHED;
            PG8_LDA(At, 0, 1); PG8_STAGE(PG8_SB(0, 0), b2, voffB); PG8_STAGE(PG8_SB(0, 1), b2 + hstep, voffB); PG8_STAGE(PG8_SA(0, 0), a2, voffA);
            PG8_WAIT_V(8); PG8_WAIT_L(0); PG8_BAR; PG8_MMA(1, 0, At, B0); PG8_MMA(1, 1, At, B1); PG8_BAR; PG8_SCHED;
            PG8_LDB(B0, 1, 0); PG8_LDB(B1, 1, 1); PG8_SCHED; PG8_LDA(At, 1, 0); PG8_STAGE(PG8_SA(0, 1), a2 + hstep, voffA);
            PG8_WAIT_V(8); PG8_WAIT_L(0); PG8_BAR; PG8_MMA(0, 0, At, B0); PG8_MMA(0, 1, At, B1); PG8_BAR; PG8_SCHED;
            PG8_LDA(At, 1, 1); PG8_STAGE(PG8_SB(1, 0), b3, voffB); PG8_STAGE(PG8_SB(1, 1), b3 + hstep, voffB); PG8_STAGE(PG8_SA(1, 0), a3, voffA);
            PG8_WAIT_V(8); PG8_WAIT_L(0); PG8_BAR; PG8_MMA(1, 0, At, B0); PG8_MMA(1, 1, At, B1); PG8_BAR; PG8_SCHED;
            } else {
            PG8_LDB(B0, 0, 0); PG8_SCHED; PG8_LDA(At, 0, 0); PG8_STAGE(PG8_SA(1, 1), a1 + hstep, voffA);
            PG8_WAIT_L(8); PG8_BAR; PG8_WAIT_L(0); PG8_MMA(0, 0, At, B0); PG8_BAR; PG8_SCHED;
            PG8_LDB(B1, 0, 1); PG8_STAGE(PG8_SB(0, 0), b2, voffB);
            PG8_BAR; PG8_WAIT_L(0); PG8_MMA(0, 1, At, B1); PG8_BAR;
            PG8_LDA(At, 0, 1); PG8_STAGE(PG8_SA(0, 0), a2, voffA);
            PG8_BAR; PG8_WAIT_L(0); PG8_MMA(1, 0, At, B0); PG8_BAR; PG8_SCHED;
            PG8_STAGE(PG8_SB(0, 1), b2 + hstep, voffB);
            PG8_WAIT_V(6); PG8_BAR; PG8_MMA(1, 1, At, B1); PG8_BAR;
            PG8_LDB(B0, 1, 0); PG8_SCHED; PG8_LDA(At, 1, 0); PG8_STAGE(PG8_SA(0, 1), a2 + hstep, voffA);
            PG8_WAIT_L(8); PG8_BAR; PG8_WAIT_L(0); PG8_MMA(0, 0, At, B0); PG8_BAR; PG8_SCHED;
            PG8_LDB(B1, 1, 1); PG8_STAGE(PG8_SB(1, 0), b3, voffB);
            PG8_BAR; PG8_WAIT_L(0); PG8_MMA(0, 1, At, B1); PG8_BAR;
            PG8_LDA(At, 1, 1); PG8_STAGE(PG8_SA(1, 0), a3, voffA);
            PG8_BAR; PG8_WAIT_L(0); PG8_MMA(1, 0, At, B0); PG8_BAR; PG8_SCHED;
            PG8_STAGE(PG8_SB(1, 1), b3 + hstep, voffB);
            PG8_WAIT_V(6); PG8_BAR; PG8_MMA(1, 1, At, B1); PG8_BAR;
            }
        }
        if constexpr (ALIGN_EPI) { if (wr == 0) PG8_BAR; }
        if constexpr (!Epi::AFTER_DRAIN) { E(acc, cur, wr, wc, fr, fq); S.done(cur); }
        if (!has_next) break;
#pragma unroll
        for (int a = 0; a < 2; ++a)
#pragma unroll
            for (int b = 0; b < 2; ++b)
#pragma unroll
                for (int m = 0; m < 4; ++m)
#pragma unroll
                    for (int n = 0; n < 2; ++n) acc[a][b][m][n] = (AccT){0, 0, 0, 0};
        cur = nxt; cA = nA; cB = nB; ++ui;
        if constexpr (ALIGN_EPI) { if (wr == 1) PG8_BAR; }
    }
    PG8_WAIT_V(0);
    if constexpr (!ALIGN_EPI) { if (wr == 0) PG8_BAR; }
    PG8_BAR;
    if constexpr (Epi::AFTER_DRAIN) { E.fused(acc, cur, wr, wc, fr, fq, lds, wid, lane); S.done(cur); }
#undef PG8_SA
#undef PG8_SB
#undef PG8_STAGE
#undef PG8_LDA
#undef PG8_LDB
#undef PG8_MMA
#undef PG8_WAIT_V
#undef PG8_WAIT_L
#undef PG8_BAR
#undef PG8_SCHED
}
}
#include <hip/hip_bf16.h>
#include <cmath>
namespace attn_body {
using bf16=__hip_bfloat16;
using bf16x8=__attribute__((ext_vector_type(8)))short;
using s16x4=__attribute__((ext_vector_type(4)))short;
using f32x16=__attribute__((ext_vector_type(16)))float;
using u32x4=__attribute__((ext_vector_type(4)))unsigned;
constexpr int BATCH=4,NHEAD=16,SEQ=4096,D=64,DM=NHEAD*D,KVP=512;
constexpr int NW=8,QBLK=32,QB=QBLK*NW,KVBLK=64,NQB=SEQ/QB;
constexpr int ATTN_PITCH=DM, ATTN_UNIT_ROWS=QB;
__device__ __forceinline__ int crow(int r,int hi){return (r&3)+8*(r>>2)+4*hi;}
#define SBAR() __builtin_amdgcn_sched_barrier(0)
__device__ __forceinline__ void cmask(f32x16&p0,f32x16&p1,int jb,int qrel,int hi){
  const float NEG=-INFINITY; int kb=64*jb+4*hi;
  #pragma unroll
  for(int r=0;r<16;++r){int kv=kb+(r&3)+8*(r>>2); if(kv>qrel)p0[r]=NEG; if(kv+32>qrel)p1[r]=NEG;}
}

constexpr int NSLOT=3, SLOTB=8192;
constexpr int LDS_K=0, LDS_V=NSLOT*SLOTB, LDS_WS=2*NSLOT*SLOTB, LDS_OST=LDS_WS+NW*64*4, LDS_SAV=LDS_OST+NW*4096, LDS_BYTES=LDS_SAV+NW*4096;
constexpr float C2=0.17677669529663687f*1.4426950408889634f;
__device__ __forceinline__ void glds16(const void*gsrc,unsigned lds_dst){unsigned keep;
  asm volatile("s_mov_b32 %0, m0\n\ts_mov_b32 m0, %2\n\ts_nop 0\n\tglobal_load_lds_dwordx4 %1, off\n\ts_mov_b32 m0, %0":"=&s"(keep):"v"(gsrc),"s"(lds_dst):"memory");}
__device__ __forceinline__ float max3f(float a,float b,float c){float r;asm("v_max3_f32 %0, %1, %2, %3":"=v"(r):"v"(a),"v"(b),"v"(c));return r;}
__device__ __forceinline__ float max2f(float a,float b){float r;asm("v_max_f32_e32 %0, %1, %2":"=v"(r):"v"(a),"v"(b));return r;}
__device__ __forceinline__ float fadd_s(float a,float b){float r;asm("v_add_f32_e32 %0, %1, %2":"=v"(r):"v"(a),"v"(b));return r;}
__device__ __forceinline__ float fsub_s(float a,float b){float r;asm("v_sub_f32_e32 %0, %1, %2":"=v"(r):"v"(a),"v"(b));return r;}
typedef float f32x2_t __attribute__((ext_vector_type(2))); typedef __bf16 bf16x2_t __attribute__((ext_vector_type(2)));
__device__ __forceinline__ unsigned cvtpk_s(float lo,float hi){f32x2_t v={lo,hi};bf16x2_t b=__builtin_convertvector(v,bf16x2_t);return __builtin_bit_cast(unsigned,b);}
#define WAIT_BAR(N) asm volatile("s_waitcnt vmcnt(" #N ") lgkmcnt(0)\n\ts_barrier":::"memory")

template<int PASS> __device__ __forceinline__ void qkt(f32x16&p0,f32x16&p1,const char*Kslot,const bf16x8*qr,const f32x16&negm,int r32,int hi){
  const char*kb=Kslot+hi*1024+r32*16+PASS*4096;
  #pragma unroll
  for(int d0=0;d0<2;++d0){
    const bf16x8 b0=*reinterpret_cast<const bf16x8*>(kb+d0*2048);
    const bf16x8 b1=*reinterpret_cast<const bf16x8*>(kb+d0*2048+512);
    if(d0==0){p0=__builtin_amdgcn_mfma_f32_32x32x16_bf16(b0,qr[0],negm,0,0,0);p1=__builtin_amdgcn_mfma_f32_32x32x16_bf16(b1,qr[0],negm,0,0,0);}
    else{p0=__builtin_amdgcn_mfma_f32_32x32x16_bf16(b0,qr[d0],p0,0,0,0);p1=__builtin_amdgcn_mfma_f32_32x32x16_bf16(b1,qr[d0],p1,0,0,0);}}
}
typedef __attribute__((address_space(3))) const char* lds_cptr;
typedef short v4i16_t __attribute__((ext_vector_type(4)));
__device__ __forceinline__ void kload8(bf16x8*kf,lds_cptr kp){
  kf[0]=*(const __attribute__((address_space(3))) bf16x8*)(kp);      kf[1]=*(const __attribute__((address_space(3))) bf16x8*)(kp+512);
  kf[2]=*(const __attribute__((address_space(3))) bf16x8*)(kp+2048); kf[3]=*(const __attribute__((address_space(3))) bf16x8*)(kp+2560);
}
__device__ __forceinline__ void kload2(bf16x8*kf,lds_cptr kp,int j){ kf[2*j]=*(const __attribute__((address_space(3))) bf16x8*)(kp+j*2048); kf[2*j+1]=*(const __attribute__((address_space(3))) bf16x8*)(kp+j*2048+512); }
__device__ __forceinline__ s16x4 vtr(lds_cptr p){ return __builtin_bit_cast(s16x4,__builtin_amdgcn_ds_read_tr16_b64_v4i16((__attribute__((address_space(3))) v4i16_t*)p)); }
__device__ __forceinline__ float rowmax(const f32x16&p0,const f32x16&p1){
  float a=max3f(p0[0],p0[1],p1[0]),b=max3f(p0[2],p0[3],p1[1]);a=max3f(a,p1[2],p1[3]);
  #pragma unroll
  for(int r=4;r<16;r+=4){a=max3f(a,p0[r],p0[r+1]);b=max3f(b,p0[r+2],p0[r+3]);a=max3f(a,p1[r],p1[r+1]);b=max3f(b,p1[r+2],p1[r+3]);}
  const float m=max2f(a,b);
  auto rr=__builtin_amdgcn_permlane32_swap(__float_as_uint(m),__float_as_uint(m),false,false);
  return max2f(__uint_as_float(rr[0]),__uint_as_float(rr[1]));
}
__device__ __forceinline__ void pv(f32x16*o,int vb,bf16x8 pa0,bf16x8 pa1,bf16x8 pa2,bf16x8 pa3){
  #pragma unroll
  for(int d0=0;d0<2;++d0){s16x4 lo[4],hi[4];
    #pragma unroll
    for(int ks=0;ks<4;++ks){
      asm volatile("ds_read_b64_tr_b16 %0,%1 offset:%c2":"=&v"(lo[ks]):"v"(vb),"i"(d0*4096+ks*1024):"memory");
      asm volatile("ds_read_b64_tr_b16 %0,%1 offset:%c2":"=&v"(hi[ks]):"v"(vb),"i"(d0*4096+ks*1024+512):"memory");}
    asm volatile("s_waitcnt lgkmcnt(0)":::"memory");SBAR();
    #define PK(k) (bf16x8){lo[k][0],lo[k][1],lo[k][2],lo[k][3],hi[k][0],hi[k][1],hi[k][2],hi[k][3]}
    o[d0]=__builtin_amdgcn_mfma_f32_32x32x16_bf16(pa0,PK(0),o[d0],0,0,0);
    o[d0]=__builtin_amdgcn_mfma_f32_32x32x16_bf16(pa1,PK(1),o[d0],0,0,0);
    o[d0]=__builtin_amdgcn_mfma_f32_32x32x16_bf16(pa2,PK(2),o[d0],0,0,0);
    o[d0]=__builtin_amdgcn_mfma_f32_32x32x16_bf16(pa3,PK(3),o[d0],0,0,0);
    #undef PK
  }
}

#ifndef ATTN_STORE16
#define ATTN_STORE16(p,v) (*(u32x4*)(p)=(v))
#endif
template<int THRL,int PASS> __device__ __forceinline__ void attn_unit(int b,int h,int qb,const bf16*Q,const bf16*__restrict__ K,const bf16*__restrict__ V,bf16*O,char*shm,float lam,const float*subw){
  int tid_=threadIdx.x; asm volatile("":"+v"(tid_)); const int tid=tid_,lane=tid&63,r32=lane&31,hi=lane>>5; const int wid=__builtin_amdgcn_readfirstlane(tid>>6);
  const long rowbase=(long)b*SEQ; const int q0=qb*QB;
  constexpr int pass=PASS; const bf16*Qw=Q+(rowbase+q0+wid*QBLK)*KVP+h*D+PASS*32;
  const bf16*Kh=K+rowbase*KVP+h*D,*Vh=V+rowbase*KVP+h*D;
  const unsigned lds0=(unsigned)(uintptr_t)shm;
  float*wsf=(float*)(shm+LDS_WS)+wid*64;
  const bf16*ksrc=Kh+(long)lane*KVP+wid*8;
  const bf16*vsrc=Vh+(long)(16*(wid&3)+(lane>>2))*KVP+(wid>>2)*32+(lane&3)*8;
  const unsigned kdst=lds0+LDS_K+wid*1024, vdst=lds0+LDS_V+wid*1024;
  #define DMA_K(t,slot) glds16(ksrc+(long)(t)*KVBLK*KVP,(unsigned)__builtin_amdgcn_readfirstlane(kdst+(slot)))
  #define DMA_V(t,slot) glds16(vsrc+(long)(t)*KVBLK*KVP,(unsigned)__builtin_amdgcn_readfirstlane(vdst+(slot)))
  const int vb0=(int)(lds0+LDS_V)+((lane>>4)&1)*32+(lane&3)*8+(4*hi+((lane&15)>>2))*64;
  const char*Kbase=shm+LDS_K; bf16x8 kf[4];
  const lds_cptr shm3=(lds_cptr)shm; const lds_cptr kp0=shm3+LDS_K+hi*1024+r32*16+PASS*4096; const lds_cptr vp0=shm3+LDS_V+((lane>>4)&1)*32+(lane&3)*8+(4*hi+((lane&15)>>2))*64;
  const int NT=(q0+QB)/KVBLK;
  DMA_K(0,0);DMA_V(0,0);DMA_K(1,SLOTB);
  bf16x8 qr[2];
  #pragma unroll
  for(int d0=0;d0<2;++d0)qr[d0]=*reinterpret_cast<const bf16x8*>(&Qw[(long)r32*KVP+d0*16+hi*8]);
  float mhat=0.f,l_reg=0.f;f32x16 o[2];o[0]=f32x16{};o[1]=f32x16{};f32x16 negm=f32x16{};asm volatile("":"+v"(negm));
  const int qrel=wid*QBLK+r32;
  #define CMASK(P0,P1,t) do{int jb_=(t)-(NT-4); if(jb_>=0)cmask(P0,P1,jb_,qrel,hi);}while(0)
  bool resc=false;
  #define START(P0,P1) do{ const float rm=rowmax(P0,P1); resc=false; \
    { const float dl=rm; mhat=fadd_s(mhat,dl); \
      _Pragma("unroll") for(int r=0;r<16;++r){P0[r]=fsub_s(P0[r],dl);P1[r]=fsub_s(P1[r],dl);} \
      _Pragma("unroll") for(int r=0;r<16;++r)negm[r]=-mhat; asm volatile("":"+v"(negm)); } \
    _Pragma("unroll") for(int r=0;r<16;++r)P0[r]=__builtin_amdgcn_exp2f(P0[r]); }while(0)
  #define RESC() do{ if(resc){ asm volatile("s_waitcnt lgkmcnt(0)":::"memory"); \
      _Pragma("unroll") for(int d_=0;d_<2;++d_) _Pragma("unroll") for(int r=0;r<16;++r)o[d_][r]*=wsf[crow(r,hi)]; } }while(0)
  f32x16 pA0,pA1,pB0,pB1;
  int sl_prev=0,sl_cur=0,sl_next=SLOTB;
  #define ROT() do{sl_prev=sl_cur;sl_cur=sl_next;sl_next=(sl_next==(NSLOT-1)*SLOTB)?0:sl_next+SLOTB;}while(0)
  DMA_K(2,2*SLOTB);
  WAIT_BAR(3);
  qkt<PASS>(pA0,pA1,Kbase,qr,negm,r32,hi);asm volatile("s_nop 15\n\ts_nop 7":"+v"(pA0),"+v"(pA1));CMASK(pA0,pA1,0);
  START(pA0,pA1);
  _Pragma("unroll") for(int r=0;r<16;++r)pA1[r]=__builtin_amdgcn_exp2f(pA1[r]);
  WAIT_BAR(0);
  DMA_K(3,0);DMA_V(1,SLOTB);
  ROT();
  kload8(kf,kp0+sl_cur);
  WAIT_BAR(2);
  s16x4 vlo[8],vhi[8]; u32x4 pw0,pw1,pw2,pw3;
  #define PKW(P,B) cvtpk_s(P[B],P[B+1])
  #define PAF(k) __builtin_bit_cast(bf16x8,pw##k)
  #define VFR(i) (bf16x8){vlo[i][0],vlo[i][1],vlo[i][2],vlo[i][3],vhi[i][0],vhi[i][1],vhi[i][2],vhi[i][3]}
  #define PIN(x) asm volatile("":"+v"(x))
  #define MX3(a,b,c) __builtin_fmaxf(__builtin_fmaxf((a),(b)),(c))
  #define GAPA(MF,A0,A1,A2,A3,W0,W1,PW) do{ MF; sacc+=A0; sacc+=A1; sacc+=A2; sacc+=A3; PIN(sacc); W0; W1; PIN(PW); SBAR(); }while(0)
  #define EX(v) __builtin_amdgcn_exp2f(v)
  #define GAPB(MF,X,B) do{ MF; X[B]=EX(X[B]); X[B+1]=EX(X[B+1]); X[B+2]=EX(X[B+2]); X[B+3]=EX(X[B+3]); PIN(X); SBAR(); }while(0)
  #define VRD(i) do{ vlo[i]=vtr(vp_+(((i)>>2)*4096+((i)&3)*1024)); vhi[i]=vtr(vp_+(((i)>>2)*4096+((i)&3)*1024+512)); }while(0)
  #define KRD(G,j) do{ if(G){ kload2(kf,kp0+sl_next,j); SBAR(); } }while(0)
  #define STEP(C0,C1,P0,P1,t,GK,GV,GL) do{ SBAR(); \
    const lds_cptr vp_=vp0+sl_prev; \
    VRD(0); SBAR(); float sacc=(P0[0]+P0[1]); \
    GAPA(C0=__builtin_amdgcn_mfma_f32_32x32x16_bf16(kf[0],qr[0],negm,0,0,0), P0[2],P0[3],P0[4],P0[5],     pw0[0]=PKW(P0,0), pw0[1]=PKW(P0,2), pw0); \
    VRD(4); SBAR(); GAPA(C1=__builtin_amdgcn_mfma_f32_32x32x16_bf16(kf[1],qr[0],negm,0,0,0), P0[6],P0[7],P0[8],P0[9],     pw0[2]=PKW(P0,4), pw0[3]=PKW(P0,6), pw0); \
    VRD(1); SBAR(); GAPA(C0=__builtin_amdgcn_mfma_f32_32x32x16_bf16(kf[2],qr[1],C0,0,0,0),   P0[10],P0[11],P0[12],P0[13], pw1[0]=PKW(P0,8), pw1[1]=PKW(P0,10), pw1); \
    VRD(5); SBAR(); GAPA(C1=__builtin_amdgcn_mfma_f32_32x32x16_bf16(kf[3],qr[1],C1,0,0,0),   P0[14],P0[15],P1[0],P1[1],   pw1[2]=PKW(P0,12),pw1[3]=PKW(P0,14), pw1); \
    VRD(2); SBAR(); GAPA((void)0,   P1[2],P1[3],P1[4],P1[5],     pw2[0]=PKW(P1,0), pw2[1]=PKW(P1,2), pw2); \
    VRD(6); SBAR(); GAPA((void)0,   P1[6],P1[7],P1[8],P1[9],     pw2[2]=PKW(P1,4), pw2[3]=PKW(P1,6), pw2); \
    VRD(3); SBAR(); GAPA((void)0,   P1[10],P1[11],P1[12],P1[13], pw3[0]=PKW(P1,8), pw3[1]=PKW(P1,10), pw3); \
    VRD(7); SBAR(); GAPA((void)0,   P1[14],P1[15],0.f,0.f,       pw3[2]=PKW(P1,12),pw3[3]=PKW(P1,14), pw3); \
    l_reg+=sacc; \
    if(GK){DMA_K((t)+3,sl_cur);} if(GV){DMA_V((t)+1,sl_next);} \
    CMASK(C0,C1,t); \
    { float a=MX3(C0[0],C0[1],C1[0]),b=MX3(C0[2],C0[3],C1[1]); a=MX3(a,C1[2],C1[3]); \
      _Pragma("unroll") for(int r=4;r<16;r+=4){a=MX3(a,C0[r],C0[r+1]);b=MX3(b,C0[r+2],C0[r+3]);a=MX3(a,C1[r],C1[r+1]);b=MX3(b,C1[r+2],C1[r+3]);} \
      float rm=__builtin_fmaxf(a,b); { auto rr=__builtin_amdgcn_permlane32_swap(__float_as_uint(rm),__float_as_uint(rm),false,false); rm=__builtin_fmaxf(__uint_as_float(rr[0]),__uint_as_float(rr[1])); } \
      resc=false; \
      if(__builtin_expect(__any(rm>(float)THRL),0)){ const float dl=__builtin_fmaxf(rm,0.f); mhat+=dl; \
        _Pragma("unroll") for(int r=0;r<16;++r){C0[r]-=dl;C1[r]-=dl;} \
        _Pragma("unroll") for(int r=0;r<16;++r)negm[r]=-mhat; asm volatile("":"+v"(negm)); \
        const float f=__builtin_amdgcn_exp2f(-dl); l_reg*=f; if(hi==0)wsf[r32]=f; resc=true; } } \
    SBAR(); \
    GAPB(o[0]=__builtin_amdgcn_mfma_f32_32x32x16_bf16(PAF(0),VFR(0),o[0],0,0,0), C0,0); \
    GAPB(o[1]=__builtin_amdgcn_mfma_f32_32x32x16_bf16(PAF(0),VFR(4),o[1],0,0,0), C0,4); \
    KRD(GL,0); GAPB(o[0]=__builtin_amdgcn_mfma_f32_32x32x16_bf16(PAF(1),VFR(1),o[0],0,0,0), C0,8); \
    KRD(GL,1); GAPB(o[1]=__builtin_amdgcn_mfma_f32_32x32x16_bf16(PAF(1),VFR(5),o[1],0,0,0), C0,12); \
    GAPB(o[0]=__builtin_amdgcn_mfma_f32_32x32x16_bf16(PAF(2),VFR(2),o[0],0,0,0), C1,0); \
    GAPB(o[1]=__builtin_amdgcn_mfma_f32_32x32x16_bf16(PAF(2),VFR(6),o[1],0,0,0), C1,4); \
    GAPB(o[0]=__builtin_amdgcn_mfma_f32_32x32x16_bf16(PAF(3),VFR(3),o[0],0,0,0), C1,8); \
    GAPB(o[1]=__builtin_amdgcn_mfma_f32_32x32x16_bf16(PAF(3),VFR(7),o[1],0,0,0), C1,12); \
    }while(0)
  int t=1;
  #undef CMASK
  #define CMASK(P0,P1,t) do{}while(0)
  for(;t+5<NT;t+=2){
    STEP(pB0,pB1,pA0,pA1,t,true,true,true);     WAIT_BAR(2); RESC(); ROT();
    STEP(pA0,pA1,pB0,pB1,t+1,true,true,true);   WAIT_BAR(2); RESC(); ROT();
  }
  #undef CMASK
  #define CMASK(P0,P1,t) do{int jb_=(t)-(NT-4); if(jb_>=0)cmask(P0,P1,jb_,qrel,hi);}while(0)
  #define ENDW(tt) do{ if((tt)+3<NT){WAIT_BAR(2);} else if((tt)+2<NT){WAIT_BAR(1);} else {WAIT_BAR(0);} }while(0)
  for(;t+1<NT;t+=2){
    STEP(pB0,pB1,pA0,pA1,t,(t+3<NT),(t+1<NT),(t+1<NT));       ENDW(t);   RESC(); ROT();
    STEP(pA0,pA1,pB0,pB1,t+1,(t+4<NT),(t+2<NT),(t+2<NT));     ENDW(t+1); RESC(); ROT();
  }
  STEP(pB0,pB1,pA0,pA1,NT-1,false,false,false); RESC();
  { float sacc=pB0[0]+pB0[1]; _Pragma("unroll") for(int r=2;r<16;++r)sacc+=pB0[r]; _Pragma("unroll") for(int r=0;r<16;++r)sacc+=pB1[r]; l_reg+=sacc;
    pw0=(u32x4){PKW(pB0,0),PKW(pB0,2),PKW(pB0,4),PKW(pB0,6)};pw1=(u32x4){PKW(pB0,8),PKW(pB0,10),PKW(pB0,12),PKW(pB0,14)};pw2=(u32x4){PKW(pB1,0),PKW(pB1,2),PKW(pB1,4),PKW(pB1,6)};pw3=(u32x4){PKW(pB1,8),PKW(pB1,10),PKW(pB1,12),PKW(pB1,14)};
    SBAR(); pv(o,vb0+sl_cur,PAF(0),PAF(1),PAF(2),PAF(3)); }
  #undef PKW
  #undef PAF
  #undef VFR
  #undef PIN
  #undef MX3
  #undef GAPA
  #undef GAPB
  #undef EX
  #undef VRD
  #undef KRD
  #undef STEP
  #undef ENDW
  {auto rr=__builtin_amdgcn_permlane32_swap(__float_as_uint(l_reg),__float_as_uint(l_reg),false,false);l_reg=__uint_as_float(rr[0])+__uint_as_float(rr[1]);}
  if(hi==0)wsf[32+r32]=l_reg;asm volatile("s_waitcnt lgkmcnt(0)":::"memory");
  float rli[16];
  #pragma unroll
  for(int r=0;r<16;++r)rli[r]=__builtin_amdgcn_rcpf(wsf[32+crow(r,hi)]);
  bf16*Ow=O+(rowbase+q0+wid*QBLK)*DM+h*D;
  { bf16*stg=(bf16*)(shm+(pass==0?LDS_SAV:LDS_OST))+wid*2048;
    #pragma unroll
    for(int r=0;r<16;++r){const int orow=crow(r,hi);
      #pragma unroll
      for(int d0=0;d0<2;++d0)stg[orow*64+d0*32+r32]=__float2bfloat16(o[d0][r]*rli[r]);}
    asm volatile("s_waitcnt lgkmcnt(0)":::"memory");
    if(pass==1){ const bf16*sav=(const bf16*)(shm+LDS_SAV)+wid*2048; const int ch=lane&7;
      float sw[8]; const float*sp=subw+ch*8; asm volatile("":"+v"(sp));
      #pragma unroll
      for(int e=0;e<8;++e)sw[e]=sp[e]*0.8f;
      #pragma unroll
      for(int i=0;i<4;++i){const int row=i*8+(lane>>3); const u32x4 v2=*(const u32x4*)(stg+row*64+ch*8); const u32x4 v1=*(const u32x4*)(sav+row*64+ch*8);
        float dd[8]; float ss=0.f;
        #pragma unroll
        for(int e=0;e<4;++e){ const unsigned a=v1[e],c=v2[e];
          const float a0=__uint_as_float(a<<16),a1=__uint_as_float(a&0xffff0000u),c0=__uint_as_float(c<<16),c1=__uint_as_float(c&0xffff0000u);
          dd[2*e]=a0-lam*c0; dd[2*e+1]=a1-lam*c1; ss+=dd[2*e]*dd[2*e]+dd[2*e+1]*dd[2*e+1]; }
        ss+=__shfl_xor(ss,1); ss+=__shfl_xor(ss,2); ss+=__shfl_xor(ss,4);
        const float rinv=1.0f/sqrtf(ss*(1.0f/64.0f)+1e-6f);
        u32x4 w;
        #pragma unroll
        for(int e=0;e<4;++e)w[e]=cvtpk_s(dd[2*e]*rinv*sw[2*e],dd[2*e+1]*rinv*sw[2*e+1]);
        ATTN_STORE16(Ow+(long)row*DM+ch*8,w);} } }
  asm volatile("s_waitcnt lgkmcnt(0)\n\ts_barrier":::"memory");
  #undef DMA_K
  #undef DMA_V
  #undef CMASK
  #undef START
  #undef RESC
  #undef ROT
}
constexpr int ATTN_LDS_BYTES=LDS_BYTES;
struct AttnTensors { const bf16* Q; const bf16* K; const bf16* V; bf16* O; };
struct AttnUnit { int bh; int qb; };
struct StaticOrder {
  int vcu, G;
  __device__ __forceinline__ explicit StaticOrder(int grid,int block):vcu((grid%8==0)?(block%8)*(grid/8)+block/8:block),G(grid){}
  __device__ __forceinline__ bool next(int i,AttnUnit&u)const{ const int L=(i>>1)*G+vcu; if(L>=256)return false; const int s=L&7; u.bh=L>>3; u.qb=(i&1)?15-s:s; return true; }
};
template<class Sched,int THRL=8> __device__ __forceinline__ void attn_phase(char*lds,const AttnTensors&T,const Sched&S,float lam,const float*subw){
  AttnUnit u;
  for(int i=0;S.next(i,u);++i){
    attn_unit<THRL,0>(u.bh>>3,u.bh&7,u.qb,T.Q,T.K,T.V,T.O,lds,lam,subw);
    attn_unit<THRL,1>(u.bh>>3,u.bh&7,u.qb,T.Q,T.K,T.V,T.O,lds,lam,subw); }
}
#undef SBAR
#undef WAIT_BAR
}
constexpr int NWAVES = 8;
constexpr int BATCH = 4, SEQ = 4096, D = 1024, M = BATCH * SEQ;
constexpr int NIN = 2560, NQP = 2048, NEXP = 16384;
constexpr float NORM_EPS = 1e-6f, LN_EPS = 1e-5f;
#ifndef REP_PHASE
#define REP_PHASE 0
#endif
#define REP_COUNT 3
#define NREP(k) ((REP_PHASE == (k)) ? REP_COUNT : 1)
#ifndef STAGE
#define STAGE 9
#endif

constexpr size_t MiB = 1u << 20;
constexpr size_t WS_CTL = 0, CTL_ZERO_BYTES = 1 * MiB;
constexpr size_t WS_WIN = 1 * MiB, WS_WO = 6 * MiB, WS_WQ = 8 * MiB, WS_KEYS = 12 * MiB, WS_ROPE = 13 * MiB, WS_SS = 14 * MiB, WS_LNS = 15 * MiB, WS_WSB = 66 * MiB;
constexpr size_t WS_U8 = 16 * MiB, WS_V8 = 32 * MiB, WS_SU = 48 * MiB, WS_SV = 48 * MiB + 65536;
constexpr size_t WS_XN = 80 * MiB, WS_MIX = 80 * MiB;
constexpr size_t WS_SA2 = 12 * MiB + 576 * 1024, WS_SBQ = 12 * MiB + 800 * 1024, WS_A8 = 224 * MiB;
constexpr size_t WS_PM = 13 * MiB + 512 * 1024;
constexpr size_t WS_SA = 12 * MiB + 512 * 1024, WS_SB = 12 * MiB + 768 * 1024;
constexpr size_t WS_Q = 112 * MiB, WS_K = 144 * MiB, WS_V = 160 * MiB, WS_U = 176 * MiB, WS_VG = 192 * MiB;
constexpr size_t WS_X1B = 112 * MiB, WS_QP = 144 * MiB, WS_IDX = 208 * MiB, WS_G = 216 * MiB, WS_END = 240 * MiB;

constexpr int RING_OFF = 0, RING_BYTES = 131072;
constexpr int LDS_BYTES = 163840;
constexpr int LDSCTL_OFF = LDS_BYTES - 1024, MISC_OFF = LDSCTL_OFF + 320;
constexpr int CW_BAR = 4096;
#ifndef USE_CG_SYNC
#define USE_CG_SYNC 0
#endif
static_assert(attn_body::ATTN_LDS_BYTES <= RING_BYTES, "attention scratch inside the ring region");

#define GAS __attribute__((address_space(1)))
#define LAS __attribute__((address_space(3)))
typedef unsigned short bf16;
typedef unsigned v4u __attribute__((ext_vector_type(4)));
typedef float f32x4 __attribute__((ext_vector_type(4)));
typedef float f32x2v __attribute__((ext_vector_type(2)));
typedef float f32x16 __attribute__((ext_vector_type(16)));
typedef short bf16x8 __attribute__((ext_vector_type(8)));
#define LDS_WAIT() asm volatile("s_waitcnt lgkmcnt(0)" ::: "memory")
__device__ __forceinline__ unsigned f2bf(float f) { unsigned u = __builtin_bit_cast(unsigned, f); return (u + 0x7fffu + ((u >> 16) & 1u)) >> 16; }
__device__ __forceinline__ unsigned pk2(float lo, float hi) { return f2bf(lo) | (f2bf(hi) << 16); }
__device__ __forceinline__ float bflo(unsigned u) { return __uint_as_float(u << 16); }
__device__ __forceinline__ float bfhi(unsigned u) { return __uint_as_float(u & 0xffff0000u); }
__device__ __forceinline__ float wave_sum(float v) {
#pragma unroll
    for (int o = 1; o < 64; o <<= 1) v += __shfl_xor(v, o);
    return v;
}
__device__ __forceinline__ float vmaxf(float a, float b) { float r; asm("v_max_f32_e32 %0, %1, %2" : "=v"(r) : "v"(a), "v"(b)); return r; }
__device__ __forceinline__ float vminf(float a, float b) { float r; asm("v_min_f32_e32 %0, %1, %2" : "=v"(r) : "v"(a), "v"(b)); return r; }
__device__ __forceinline__ float gelu_exact(float v) { return 0.5f * v * (1.0f + erff(v * 0.70710678118654752f)); }

typedef GAS unsigned gu32;
#define RLX_AGENT __ATOMIC_RELAXED, __HIP_MEMORY_SCOPE_AGENT
#define XB_TMO      128
#define XB_XCNT(j)  (256  + 64 * (j))
#define XB_XSUB(j)  (1280 + 64 * (j))
#define XB_XGEN(j)  (2304 + 64 * (j))
#define XB_TOP      3328
#define XB_TOPGEN   3392
#define XCD_BAR_WORDS 3456
#define XB_SPIN_CAP (1u << 18)

__device__ __forceinline__ unsigned xb_ld(unsigned* p)              { return __hip_atomic_load(p, __ATOMIC_RELAXED, __HIP_MEMORY_SCOPE_AGENT); }
__device__ __forceinline__ unsigned xb_add(unsigned* p, unsigned v) { return __hip_atomic_fetch_add(p, v, __ATOMIC_RELAXED, __HIP_MEMORY_SCOPE_AGENT); }
__device__ __forceinline__ unsigned xb_xcc_id() { return (unsigned)__builtin_amdgcn_s_getreg((3 << 11) | 20) & 0xFu; }
#define XB_SPIN(cond, bar) do { unsigned _sp = 0; while (cond) { __builtin_amdgcn_s_sleep(1); \
    if ((++_sp & 255u) == 0u) { if (xb_ld(&(bar)[XB_TMO])) break; if (_sp > XB_SPIN_CAP) { atomicAdd(&(bar)[XB_TMO], 1u); break; } } } } while (0)

struct XcdBarrier {
    unsigned* bar; unsigned x;
    volatile LAS unsigned* st;
};

__device__ __forceinline__ XcdBarrier xcd_barrier_post(unsigned* bar, volatile LAS unsigned* st) {
    XcdBarrier b; b.bar = bar; b.x = xb_xcc_id(); b.st = st;
    if (threadIdx.x == 0) (void)xb_add(&bar[XB_XCNT(b.x)], 1u);
    return b;
}
__device__ __forceinline__ void xcd_barrier_complete(unsigned* bar, unsigned x, unsigned& nloc, unsigned& nx) {
    const unsigned G = gridDim.x * gridDim.y * gridDim.z;
    unsigned sum, cnt, mine, sp = 0u;
    for (;;) {
        sum = 0u; cnt = 0u; mine = 0u;
#pragma unroll
        for (unsigned j = 0; j < 16; ++j) { const unsigned c = xb_ld(&bar[XB_XCNT(j)]); sum += c; cnt += (c > 0u) ? 1u : 0u; mine = (j == x) ? c : mine; }
        if (sum == G) break;
        __builtin_amdgcn_s_sleep(1);
        if ((++sp & 255u) == 0u) { if (xb_ld(&bar[XB_TMO])) break; if (sp > XB_SPIN_CAP) { atomicAdd(&bar[XB_TMO], 1u); break; } }
    }
    nloc = mine > 0u ? mine : 1u; nx = cnt > 0u ? cnt : 1u;
}

__device__ __forceinline__ void xcd_barrier(const XcdBarrier& b) {
    asm volatile("s_waitcnt vmcnt(0)" ::: "memory");
    __syncthreads();
    if (threadIdx.x == 0) {
        unsigned* bar = b.bar;
        __builtin_amdgcn_s_waitcnt(0);
        unsigned nloc = b.st[0], nx = b.st[1];
        if (nloc == 0u) { xcd_barrier_complete(bar, b.x, nloc, nx); b.st[0] = nloc; b.st[1] = nx; }
        const unsigned old = xb_add(&bar[XB_XSUB(b.x)], 1u);
        const unsigned gen = old / nloc;
        if (old + 1u == (gen + 1u) * nloc) {
            __builtin_amdgcn_fence(__ATOMIC_RELEASE, "agent");
            asm volatile("s_waitcnt vmcnt(0)" ::: "memory");
            const unsigned og = xb_add(&bar[XB_TOP], 1u);
            const unsigned tg = og / nx;
            if (og + 1u == (tg + 1u) * nx) xb_add(&bar[XB_TOPGEN], 1u);
            else XB_SPIN(xb_ld(&bar[XB_TOPGEN]) == tg, bar);
            __builtin_amdgcn_fence(__ATOMIC_ACQUIRE, "agent");
            xb_add(&bar[XB_XGEN(b.x)], 1u);
            asm volatile("s_waitcnt vmcnt(0)" ::: "memory");
        } else {
            XB_SPIN(xb_ld(&bar[XB_XGEN(b.x)]) == gen, bar);
            __builtin_amdgcn_fence(__ATOMIC_ACQUIRE, "agent");
            asm volatile("s_waitcnt vmcnt(0)" ::: "memory");
        }
    }
    __syncthreads();
}

struct Args { const float* in[20]; float* out; unsigned char* ws; };
struct Frame {
    LAS unsigned char* lds;
    int tid, lane, wave, vcu, G;
    float* out; unsigned char* ws;
};

__device__ __forceinline__ void frame_refresh(Frame& F) { int t = threadIdx.x; asm volatile("" : "+v"(t)); F.tid = t; F.lane = t & 63; F.wave = __builtin_amdgcn_readfirstlane(t >> 6); }
__device__ __forceinline__ void p0_transpose_item(const float* W, int K, int N, bf16* WT, LAS float* scr, int item, int lane, const float* kscale) {
    const int nblk = N / 32, kb = item / nblk, nb = item % nblk, k0 = 64 * kb, n0 = 32 * nb;
#pragma unroll 8
    for (int i = 0; i < 32; ++i) { const int kk = 2 * i + (lane >> 5); float v = W[(size_t)(k0 + kk) * N + n0 + (lane & 31)]; if (kscale) v *= kscale[k0 + kk]; scr[kk * 33 + (lane & 31)] = v; }
    LDS_WAIT(); asm volatile("" ::: "memory");
    const int c = lane & 7;
#pragma unroll
    for (int j = 0; j < 4; ++j) { const int n = (lane >> 3) + 8 * j; const LAS float* s = scr + (8 * c) * 33 + n;
        v4u o; o.x = pk2(s[0 * 33], s[1 * 33]); o.y = pk2(s[2 * 33], s[3 * 33]); o.z = pk2(s[4 * 33], s[5 * 33]); o.w = pk2(s[6 * 33], s[7 * 33]);
        *(GAS v4u*)(WT + (size_t)(n0 + n) * K + k0 + 8 * c) = o; }
    LDS_WAIT(); asm volatile("" ::: "memory");
}
__device__ __forceinline__ unsigned pack4_i8(float a, float b, float c, float d) {
    const int qa = __float2int_rn(a), qb = __float2int_rn(b), qc = __float2int_rn(c), qd = __float2int_rn(d);
    return (unsigned)(qa & 255) | ((unsigned)(qb & 255) << 8) | ((unsigned)(qc & 255) << 16) | ((unsigned)qd << 24);
}
__device__ __forceinline__ void rms_row_to_bf16(const float* xrow, const float* w, bf16* orow, int lane) {
    const GAS f32x4* xr = (const GAS f32x4*)xrow + lane; const GAS f32x4* wr = (const GAS f32x4*)w + lane;
    f32x4 v[4]; float s = 0.f;
#pragma unroll
    for (int j = 0; j < 4; ++j) { v[j] = xr[64 * j]; s += (v[j].x * v[j].x + v[j].y * v[j].y) + (v[j].z * v[j].z + v[j].w * v[j].w); }
    const float r = 1.f / sqrtf(wave_sum(s) * (1.f / D) + NORM_EPS);
    GAS unsigned long long* o8 = (GAS unsigned long long*)orow + lane;
#pragma unroll
    for (int j = 0; j < 4; ++j) { const f32x4 g = wr[64 * j]; o8[64 * j] = (unsigned long long)pk2(v[j].x * r * g.x, v[j].y * r * g.y) | ((unsigned long long)pk2(v[j].z * r * g.z, v[j].w * r * g.w) << 32); }
}
__device__ __forceinline__ void rms_row_to_i8(const float* xrow, const float* w, unsigned char* orow, float* sa, int lane) {
    const GAS f32x4* xr = (const GAS f32x4*)xrow + lane; const GAS f32x4* wr = (const GAS f32x4*)w + lane;
    f32x4 v[4]; float s = 0.f;
#pragma unroll
    for (int j = 0; j < 4; ++j) { v[j] = xr[64 * j]; s += (v[j].x * v[j].x + v[j].y * v[j].y) + (v[j].z * v[j].z + v[j].w * v[j].w); }
    const float r = 1.f / sqrtf(wave_sum(s) * (1.f / D) + NORM_EPS);
    float am = 0.f;
#pragma unroll
    for (int j = 0; j < 4; ++j) { const f32x4 g = wr[64 * j]; v[j].x *= r * g.x; v[j].y *= r * g.y; v[j].z *= r * g.z; v[j].w *= r * g.w;
        am = fmaxf(am, fmaxf(fmaxf(fabsf(v[j].x), fabsf(v[j].y)), fmaxf(fabsf(v[j].z), fabsf(v[j].w)))); }
#pragma unroll
    for (int o = 1; o < 64; o <<= 1) am = fmaxf(am, __shfl_xor(am, o));
    const float sc = am > 0.f ? am * (1.f / 127.f) : 1.f, inv = 1.f / sc;
    GAS unsigned* o4 = (GAS unsigned*)orow + lane;
#pragma unroll
    for (int j = 0; j < 4; ++j) o4[64 * j] = pack4_i8(v[j].x * inv, v[j].y * inv, v[j].z * inv, v[j].w * inv);
    if (lane == 0) *sa = sc;
}
__device__ __forceinline__ void cvt_f32_bf16(const float* src, bf16* dst, size_t n8, size_t gtid, size_t nthr) {
    for (size_t i = gtid; i < n8; i += nthr) { const f32x4 a = *(const GAS f32x4*)(src + i * 8), b = *(const GAS f32x4*)(src + i * 8 + 4);
        v4u o; o.x = pk2(a.x, a.y); o.y = pk2(a.z, a.w); o.z = pk2(b.x, b.y); o.w = pk2(b.z, b.w); *(GAS v4u*)(dst + i * 8) = o; }
}
__device__ __forceinline__ void fp8_table_row(Frame& F, const Args& args, int r) {
    const int tb = r >= NEXP, e = r - tb * NEXP;
    const float* src = args.in[17 + tb] + (size_t)e * D + 16 * F.lane;
    const f32x4 a = *(const GAS f32x4*)src, b = *(const GAS f32x4*)(src + 4), c = *(const GAS f32x4*)(src + 8), d = *(const GAS f32x4*)(src + 12);
    float am = fmaxf(fmaxf(fmaxf(fabsf(a.x), fabsf(a.y)), fmaxf(fabsf(a.z), fabsf(a.w))), fmaxf(fmaxf(fabsf(b.x), fabsf(b.y)), fmaxf(fabsf(b.z), fabsf(b.w))));
    am = fmaxf(am, fmaxf(fmaxf(fmaxf(fabsf(c.x), fabsf(c.y)), fmaxf(fabsf(c.z), fabsf(c.w))), fmaxf(fmaxf(fabsf(d.x), fabsf(d.y)), fmaxf(fabsf(d.z), fabsf(d.w)))));
#pragma unroll
    for (int o = 1; o < 64; o <<= 1) am = fmaxf(am, __shfl_xor(am, o));
    const float sc = am > 0.f ? am * (1.f / 224.f) : 1.f, inv = 1.f / sc;
    v4u w; int t;
    t = __builtin_amdgcn_cvt_pk_fp8_f32(a.x * inv, a.y * inv, 0, false); t = __builtin_amdgcn_cvt_pk_fp8_f32(a.z * inv, a.w * inv, t, true); w.x = (unsigned)t;
    t = __builtin_amdgcn_cvt_pk_fp8_f32(b.x * inv, b.y * inv, 0, false); t = __builtin_amdgcn_cvt_pk_fp8_f32(b.z * inv, b.w * inv, t, true); w.y = (unsigned)t;
    t = __builtin_amdgcn_cvt_pk_fp8_f32(c.x * inv, c.y * inv, 0, false); t = __builtin_amdgcn_cvt_pk_fp8_f32(c.z * inv, c.w * inv, t, true); w.z = (unsigned)t;
    t = __builtin_amdgcn_cvt_pk_fp8_f32(d.x * inv, d.y * inv, 0, false); t = __builtin_amdgcn_cvt_pk_fp8_f32(d.z * inv, d.w * inv, t, true); w.w = (unsigned)t;
    *(GAS v4u*)(F.ws + (tb ? WS_V8 : WS_U8) + (size_t)(F.lane >> 3) * ((size_t)NEXP * 128) + (size_t)e * 128 + 16 * (F.lane & 7)) = w;
    if (F.lane == 0) ((float*)(F.ws + (tb ? WS_SV : WS_SU)))[e] = sc;
}
__device__ __forceinline__ void int8_table_row(Frame& F, const Args& args, int r, const f32x4 (&fw4)[4]) {
    const int tb = r >= NEXP, e = r - tb * NEXP;
    const float* src = args.in[17 + tb] + (size_t)e * D + 16 * F.lane;
    f32x4 a = *(const GAS f32x4*)src, b = *(const GAS f32x4*)(src + 4), c = *(const GAS f32x4*)(src + 8), d = *(const GAS f32x4*)(src + 12);
    if (!tb) { a *= fw4[0]; b *= fw4[1]; c *= fw4[2]; d *= fw4[3]; }
    float am = fmaxf(fmaxf(fmaxf(fabsf(a.x), fabsf(a.y)), fmaxf(fabsf(a.z), fabsf(a.w))), fmaxf(fmaxf(fabsf(b.x), fabsf(b.y)), fmaxf(fabsf(b.z), fabsf(b.w))));
    am = fmaxf(am, fmaxf(fmaxf(fmaxf(fabsf(c.x), fabsf(c.y)), fmaxf(fabsf(c.z), fabsf(c.w))), fmaxf(fmaxf(fabsf(d.x), fabsf(d.y)), fmaxf(fabsf(d.z), fabsf(d.w)))));
#pragma unroll
    for (int o = 1; o < 64; o <<= 1) am = fmaxf(am, __shfl_xor(am, o));
    const float sc = am > 0.f ? am * (1.f / 127.f) : 1.f, inv = 1.f / sc;
    v4u w; w.x = pack4_i8(a.x * inv, a.y * inv, a.z * inv, a.w * inv); w.y = pack4_i8(b.x * inv, b.y * inv, b.z * inv, b.w * inv);
    w.z = pack4_i8(c.x * inv, c.y * inv, c.z * inv, c.w * inv); w.w = pack4_i8(d.x * inv, d.y * inv, d.z * inv, d.w * inv);
    *(GAS v4u*)(F.ws + (tb ? WS_V8 : WS_U8) + (size_t)(F.lane >> 3) * ((size_t)NEXP * 128) + (size_t)e * 128 + 16 * (F.lane & 7)) = w;
    if (F.lane == 0) ((float*)(F.ws + (tb ? WS_SV : WS_SU)))[e] = sc;
}
__device__ __forceinline__ void p0_win_strip(Frame& F, const float* W0, int N, const float* kscale, unsigned char* WT0, float* SBd, int strip) {
    LAS float* scr = (LAS float*)(F.lds + RING_OFF); LAS float* pm = scr + 1024 * 33;
    const float* W = W0 + 32 * strip; const int c = F.tid & 31, part = F.tid >> 5;
#pragma unroll 1
    for (int h = 0; h < 2; ++h) { float t[32];
#pragma unroll
      for (int i = 0; i < 32; ++i) t[i] = W[(size_t)((h * 32 + i) * 16 + part) * N + c];
#pragma unroll
      for (int i = 0; i < 32; ++i) { const int k = (h * 32 + i) * 16 + part; float v = t[i]; if (kscale) v *= kscale[k]; scr[k * 33 + c] = v; } }
    __syncthreads();
    { float am = 0.f;
#pragma unroll 8
      for (int i = 0; i < 64; ++i) am = fmaxf(am, fabsf(scr[(part * 64 + i) * 33 + c]));
      pm[part * 32 + c] = am; }
    __syncthreads();
    float am = 0.f;
#pragma unroll
    for (int p = 0; p < 16; ++p) am = fmaxf(am, pm[p * 32 + c]);
    const float sc = am > 0.f ? am * (1.f / 127.f) : 1.f, inv = 1.f / sc;
    if (part == 0) SBd[32 * strip + c] = sc;
    unsigned char* WT = WT0 + (size_t)(32 * strip + c) * D;
#pragma unroll
    for (int j = 0; j < 4; ++j) { const int kc = part + 16 * j; const LAS float* p = scr + (16 * kc) * 33 + c;
        v4u o; o.x = pack4_i8(p[0 * 33] * inv, p[1 * 33] * inv, p[2 * 33] * inv, p[3 * 33] * inv); o.y = pack4_i8(p[4 * 33] * inv, p[5 * 33] * inv, p[6 * 33] * inv, p[7 * 33] * inv);
        o.z = pack4_i8(p[8 * 33] * inv, p[9 * 33] * inv, p[10 * 33] * inv, p[11 * 33] * inv); o.w = pack4_i8(p[12 * 33] * inv, p[13 * 33] * inv, p[14 * 33] * inv, p[15 * 33] * inv);
        *(GAS v4u*)(WT + 16 * kc) = o; }
    __syncthreads();
}
__device__ __forceinline__ void p0_prologue(Frame& F, const Args& args) {
    LAS float* scr = (LAS float*)(F.lds + RING_OFF + F.wave * 16384);
    const int gw = F.vcu * NWAVES + F.wave, NGW = F.G * NWAVES;
    constexpr int I_IN = (D / 64) * (NIN / 32), I_O = (D / 64) * (D / 32), I_Q = (D / 64) * (NQP / 32);
    constexpr int NSTRIP_IN = NIN / 32, NSTRIP = NSTRIP_IN + NQP / 32, NITEMS = I_O;
    static_assert(I_IN > 0 && I_Q > 0 && NSTRIP == 144, "strip split");
    const bool stripwg = F.vcu < NSTRIP;
    if (F.vcu < NSTRIP_IN) p0_win_strip(F, args.in[2], NIN, nullptr, F.ws + WS_WIN, (float*)(F.ws + WS_SB), F.vcu);
    else if (stripwg) p0_win_strip(F, args.in[15], NQP, args.in[14], F.ws + WS_WQ, (float*)(F.ws + WS_SBQ), F.vcu - NSTRIP_IN);
    else {
        const int gw2 = (F.vcu - NSTRIP) * NWAVES + F.wave, NGW2 = (F.G - NSTRIP) * NWAVES;
        for (int it = gw2; it < NITEMS; it += NGW2) {
            int r = it;
            p0_transpose_item(args.in[13], D, D, (bf16*)(F.ws + WS_WO), scr, r, F.lane, nullptr);
        }
        for (int m = 5 * NGW + gw2; m < M; m += NGW2) rms_row_to_i8(args.in[0] + (size_t)m * D, args.in[1], F.ws + WS_XN + (size_t)m * D, (float*)(F.ws + WS_SA) + m, F.lane);
    }
    for (int m = gw; m < 5 * NGW; m += NGW) rms_row_to_i8(args.in[0] + (size_t)m * D, args.in[1], F.ws + WS_XN + (size_t)m * D, (float*)(F.ws + WS_SA) + m, F.lane);
    const size_t gtid = (size_t)F.vcu * (NWAVES * 64) + F.tid, nthr = (size_t)F.G * (NWAVES * 64);
    { const f32x4 one4[4] = {{1.f, 1.f, 1.f, 1.f}, {1.f, 1.f, 1.f, 1.f}, {1.f, 1.f, 1.f, 1.f}, {1.f, 1.f, 1.f, 1.f}}; for (int r = NEXP + gw; r < 2 * NEXP; r += NGW) int8_table_row(F, args, r, one4); }
    cvt_f32_bf16(args.in[16], (bf16*)(F.ws + WS_KEYS), (size_t)2 * 128 * 128 / 8, gtid, nthr);
    for (size_t i = gtid; i < (size_t)M; i += nthr) ((GAS v4u*)(F.ws + WS_PM))[i] = (v4u){0u, 0u, 0u, 0u};
    for (size_t i = gtid; i < (size_t)8 * 128 * 128 / 8; i += nthr) {
        const int t = (int)((i >> 4) & 127), s0 = (int)(i & 15) * 8; const f32x4 a = *(const GAS f32x4*)(args.in[10] + i * 8), b = *(const GAS f32x4*)(args.in[10] + i * 8 + 4);
        v4u o; o.x = pk2(s0 + 0 <= t ? a.x : 0.f, s0 + 1 <= t ? a.y : 0.f); o.y = pk2(s0 + 2 <= t ? a.z : 0.f, s0 + 3 <= t ? a.w : 0.f); o.z = pk2(s0 + 4 <= t ? b.x : 0.f, s0 + 5 <= t ? b.y : 0.f); o.w = pk2(s0 + 6 <= t ? b.z : 0.f, s0 + 7 <= t ? b.w : 0.f);
        *(GAS v4u*)((bf16*)(F.ws + WS_WSB) + i * 8) = o; }
    float* rope = (float*)(F.ws + WS_ROPE);
    for (size_t e = gtid; e < (size_t)SEQ * 16; e += nthr) {
        const int pos = (int)(e >> 4), f = (int)(e & 15), f4 = f & 3, fd = f >> 2;
        float inv = (f4 == 0) ? 1.0f : (f4 == 1) ? 5.623413252e-01f : (f4 == 2) ? 3.162277660e-01f : 1.778279410e-01f;
        inv *= (fd == 0) ? 1.0f : (fd == 1) ? 0.1f : (fd == 2) ? 0.01f : 0.001f;
        const float ang = (float)pos * inv;
        const double rev = (double)ang * 0.15915494309189533577; const float fr = (float)(rev - floor(rev));
        rope[2 * e] = __builtin_amdgcn_cosf(fr); rope[2 * e + 1] = __builtin_amdgcn_sinf(fr);
    }
}

__device__ __forceinline__ int crow32(int r, int hi) { return (r & 3) + 8 * (r >> 2) + 4 * hi; }
__device__ __forceinline__ void sgu_item(Frame& F, const Args& args, int chunk, int hg) {
    constexpr int VROW = 272;
    LAS f32x2v* ST = (LAS f32x2v*)(F.lds + RING_OFF);
    LAS unsigned char* VT = F.lds + RING_OFF + 1024;
    const bf16* VG = (const bf16*)(F.ws + WS_VG); const bf16* U = (const bf16*)(F.ws + WS_U); bf16* MIX = (bf16*)(F.ws + WS_MIX);
    const int row0 = chunk * 128, lane = F.lane;
    if (F.tid < 128) { const float* lp = (const float*)(F.ws + WS_LNS) + (size_t)(row0 + F.tid) * 16; float s1 = 0.f, s2 = 0.f;
#pragma unroll
        for (int q = 0; q < 4; ++q) { const f32x4 v = *(const GAS f32x4*)(lp + 4 * q); s1 += v.x + v.z; s2 += v.y + v.w; }
        const float mean = s1 * (1.f / 512.f), var = fmaxf(s2 * (1.f / 512.f) - mean * mean, 0.f);
        ST[F.tid] = (f32x2v){mean, 1.f / sqrtf(var + LN_EPS)}; }
    __syncthreads();
#pragma unroll 4
    for (int k = 0; k < 8; ++k) { const int task = F.wave * 8 + k, hl = task >> 4, sb = task & 15, ch = (hg * 4 + hl) * 64 + lane;
        const float lw = args.in[8][ch], lb = args.in[9][ch];
        float y[8];
#pragma unroll
        for (int e = 0; e < 8; ++e) { const int sidx = sb * 8 + e; const float v = __uint_as_float((unsigned)VG[(size_t)(row0 + sidx) * 512 + ch] << 16); const f32x2v st = ST[sidx]; y[e] = (v - st.x) * st.y * lw + lb; }
        *(LAS v4u*)(VT + (hl * 64 + lane) * VROW + sb * 16) = (v4u){pk2(y[0], y[1]), pk2(y[2], y[3]), pk2(y[4], y[5]), pk2(y[6], y[7])}; }
    __syncthreads();
    const int hl = F.wave & 3, th = F.wave >> 2, h = hg * 4 + hl, r32 = lane & 31, hi = lane >> 5;
    const bf16* Wh = (const bf16*)(F.ws + WS_WSB) + (size_t)h * 128 * 128;
    const float onw0 = 0.f; (void)onw0;
#pragma unroll
    for (int ti = 0; ti < 2; ++ti) {
        const int T = 2 * th + ti, t = 32 * T + r32;
        f32x16 acc0 = {}, acc1 = {};
        const bf16* wrow = Wh + (size_t)t * 128 + 8 * hi;
        const LAS unsigned char* va = VT + (hl * 64 + r32) * VROW + 16 * hi;
        for (int ks = 0; ks < 2 * T + 2; ++ks) {
            const bf16x8 bfrag = *(const GAS bf16x8*)(wrow + 16 * ks);
            const bf16x8 a0 = *(const LAS bf16x8*)(va + 32 * ks), a1 = *(const LAS bf16x8*)(va + 32 * VROW + 32 * ks);
            acc0 = __builtin_amdgcn_mfma_f32_32x32x16_bf16(a0, bfrag, acc0, 0, 0, 0);
            acc1 = __builtin_amdgcn_mfma_f32_32x32x16_bf16(a1, bfrag, acc1, 0, 0, 0);
        }
        const size_t row = (size_t)(row0 + t); const float bias = args.in[11][h * 128 + t];
        const bf16* up = U + row * 512 + h * 64 + 4 * hi; bf16* op = MIX + row * 1024 + 512 + h * 64 + 4 * hi; const float* nw = args.in[12] + h * 64 + 4 * hi;
        float o[32]; float ssq = 0.f;
#pragma unroll
        for (int di = 0; di < 2; ++di)
#pragma unroll
            for (int g = 0; g < 4; ++g) { const f32x2v uu = *(const GAS f32x2v*)(up + 32 * di + 8 * g); const unsigned u0 = __float_as_uint(uu.x), u1 = __float_as_uint(uu.y);
                const float m0 = (di ? acc1[4 * g] : acc0[4 * g]) + bias, m1 = (di ? acc1[4 * g + 1] : acc0[4 * g + 1]) + bias, m2 = (di ? acc1[4 * g + 2] : acc0[4 * g + 2]) + bias, m3 = (di ? acc1[4 * g + 3] : acc0[4 * g + 3]) + bias;
                const float o0 = bflo(u0) * m0, o1 = bfhi(u0) * m1, o2 = bflo(u1) * m2, o3 = bfhi(u1) * m3;
                o[di * 16 + 4 * g] = o0; o[di * 16 + 4 * g + 1] = o1; o[di * 16 + 4 * g + 2] = o2; o[di * 16 + 4 * g + 3] = o3; ssq += (o0 * o0 + o1 * o1) + (o2 * o2 + o3 * o3); }
        ssq += __shfl_xor(ssq, 32);
        const float rn = 1.f / sqrtf(ssq * (1.f / 64.f) + NORM_EPS);
#pragma unroll
        for (int di = 0; di < 2; ++di)
#pragma unroll
            for (int g = 0; g < 4; ++g) { const f32x4 wv = *(const GAS f32x4*)(nw + 32 * di + 8 * g); const int b = di * 16 + 4 * g;
                f32x2v pk; pk.x = __uint_as_float(pk2(o[b] * rn * wv.x, o[b + 1] * rn * wv.y)); pk.y = __uint_as_float(pk2(o[b + 2] * rn * wv.z, o[b + 3] * rn * wv.w));
                *(GAS f32x2v*)(op + 32 * di + 8 * g) = pk; }
    }
    __syncthreads();
}

#define CE16(X, i, j) { const float a_ = X[i], b_ = X[j]; X[i] = vmaxf(a_, b_); X[j] = vminf(a_, b_); }
#define SORT16(X) do { CE16(X,0,1) CE16(X,2,3) CE16(X,0,2) CE16(X,1,3) CE16(X,1,2) CE16(X,4,5) CE16(X,6,7) CE16(X,4,6) CE16(X,5,7) CE16(X,5,6) CE16(X,0,4) CE16(X,2,6) CE16(X,2,4) CE16(X,1,5) CE16(X,3,7) CE16(X,3,5) CE16(X,1,2) CE16(X,3,4) CE16(X,5,6) CE16(X,8,9) CE16(X,10,11) CE16(X,8,10) CE16(X,9,11) CE16(X,9,10) CE16(X,12,13) CE16(X,14,15) CE16(X,12,14) CE16(X,13,15) CE16(X,13,14) CE16(X,8,12) CE16(X,10,14) CE16(X,10,12) CE16(X,9,13) CE16(X,11,15) CE16(X,11,13) CE16(X,9,10) CE16(X,11,12) CE16(X,13,14) CE16(X,0,8) CE16(X,4,12) CE16(X,4,8) CE16(X,2,10) CE16(X,6,14) CE16(X,6,10) CE16(X,2,4) CE16(X,6,8) CE16(X,10,12) CE16(X,1,9) CE16(X,5,13) CE16(X,5,9) CE16(X,3,11) CE16(X,7,15) CE16(X,7,11) CE16(X,3,5) CE16(X,7,9) CE16(X,11,13) CE16(X,1,2) CE16(X,3,4) CE16(X,5,6) CE16(X,7,8) CE16(X,9,10) CE16(X,11,12) CE16(X,13,14) } while (0)
#define MERGE16(T, X) do { _Pragma("unroll") for (int q_ = 0; q_ < 16; ++q_) T[q_] = vmaxf(T[q_], X[15 - q_]); \
    _Pragma("unroll") for (int st_ = 8; st_ >= 1; st_ >>= 1) _Pragma("unroll") for (int q_ = 0; q_ < 16; ++q_) if ((q_ & st_) == 0) CE16(T, q_, q_ + st_) } while (0)
#define INS16(T, X) do { _Pragma("unroll") for (int q_ = 0; q_ < 16; ++q_) { const float h_ = vmaxf(T[q_], X); X = vminf(T[q_], X); T[q_] = h_; } } while (0)
__device__ __forceinline__ void p5_unit(Frame& F, int row0) {
    LAS unsigned char* KL = F.lds + RING_OFF;
    LAS float* TV = (LAS float*)(F.lds + RING_OFF + 65536);
    const bf16* QP = (const bf16*)(F.ws + WS_QP); const bf16* KB = (const bf16*)(F.ws + WS_KEYS);
    const int lane = F.lane, r32 = lane & 31, hi = lane >> 5;
#define P5_QLOAD(QF, kk) do { const int task_ = F.wave * 4 + (kk), hl_ = task_ >> 2, c_ = (task_ >> 1) & 1, tg_ = task_ & 1; \
        const bf16* qrow_ = QP + (size_t)(row0 + tg_ * 32 + r32) * NQP + hl_ * 256 + c_ * 128 + hi * 8; \
        _Pragma("unroll") for (int ks = 0; ks < 8; ++ks) QF[ks] = *(const GAS bf16x8*)(qrow_ + ks * 16); } while (0)
    bf16x8 qfA[8], qfB[8], qfC[8], qfD[8];
    P5_QLOAD(qfA, 0); P5_QLOAD(qfB, 1); P5_QLOAD(qfC, 2); P5_QLOAD(qfD, 3);
#pragma unroll
    for (int i = 0; i < 8; ++i) { const int chunk = F.tid + i * 512, ck = chunk >> 4, ch = chunk & 15;
        *(LAS v4u*)(KL + ck * 256 + ((ch ^ (ck & 15)) << 4)) = *(const GAS v4u*)(KB + (size_t)chunk * 8); }
    __syncthreads();
#pragma unroll
    for (int k = 0; k < 4; ++k) {
        const int task = F.wave * 4 + k, hl = task >> 2, c = (task >> 1) & 1, tg = task & 1;
        bf16x8 (&qf)[8] = (k == 0) ? qfA : (k == 1) ? qfB : (k == 2) ? qfC : qfD;
        float t[16];
#pragma unroll
        for (int i = 0; i < 4; ++i) {
            f32x16 acc = {};
#pragma unroll
            for (int ks = 0; ks < 8; ++ks) { const int key = 32 * i + r32; const bf16x8 a = *(const LAS bf16x8*)(KL + (c * 128 + key) * 256 + (((2 * ks + hi) ^ (key & 15)) << 4)); acc = __builtin_amdgcn_mfma_f32_32x32x16_bf16(a, qf[ks], acc, 0, 0, 0); }
            float x[16];
#pragma unroll
            for (int r = 0; r < 16; ++r) { const unsigned key = (unsigned)(32 * i + (r & 3) + 8 * (r >> 2)) | (unsigned)(4 * hi);
                x[r] = __uint_as_float((__float_as_uint(acc[r]) & ~0x7fu) | key); }
            SORT16(x);
            if (i == 0) {
#pragma unroll
                for (int q = 0; q < 16; ++q) t[q] = x[q];
            } else MERGE16(t, x);
        }
        float m[16];
#pragma unroll
        for (int q = 0; q < 16; ++q) { const float p = __shfl_xor(t[15 - q], 32); m[q] = vmaxf(t[q], p); }
#pragma unroll
        for (int st = 8; st >= 1; st >>= 1)
#pragma unroll
            for (int q = 0; q < 16; ++q) if ((q & st) == 0) { const float a = m[q], b = m[q + st]; m[q] = vmaxf(a, b); m[q + st] = vminf(a, b); }
        if (hi == 0) { LAS f32x4* dst = (LAS f32x4*)(TV + ((hl * 2 + c) * 64 + tg * 32 + r32) * 20);
#pragma unroll
            for (int q = 0; q < 4; ++q) dst[q] = (f32x4){m[4 * q], m[4 * q + 1], m[4 * q + 2], m[4 * q + 3]}; }
    }
#undef P5_QLOAD
    __syncthreads();
    {
        const int tok = F.tid & 63, hl = F.tid >> 6, head = hl; const size_t row = (size_t)(row0 + tok);
        const LAS float* pa = TV + ((hl * 2 + 0) * 64 + tok) * 20; const LAS float* pb = TV + ((hl * 2 + 1) * 64 + tok) * 20;
        float a[16], b[16];
#pragma unroll
        for (int q = 0; q < 4; ++q) { const f32x4 va = ((const LAS f32x4*)pa)[q], vb = ((const LAS f32x4*)pb)[q];
            a[4 * q] = va.x; a[4 * q + 1] = va.y; a[4 * q + 2] = va.z; a[4 * q + 3] = va.w; b[4 * q] = vb.x; b[4 * q + 1] = vb.y; b[4 * q + 2] = vb.z; b[4 * q + 3] = vb.w; }
        float t[16], x[16];
#define CAND(i, j) __uint_as_float((__float_as_uint(a[i] + b[j]) & ~0xffu) | (unsigned)((i) * 16 + (j)))
        t[0] = CAND(0, 0); t[1] = CAND(0, 1); t[2] = CAND(0, 2); t[3] = CAND(0, 3); t[4] = CAND(0, 4); t[5] = CAND(0, 5); t[6] = CAND(0, 6); t[7] = CAND(0, 7);
        t[8] = CAND(0, 8); t[9] = CAND(0, 9); t[10] = CAND(0, 10); t[11] = CAND(0, 11); t[12] = CAND(0, 12); t[13] = CAND(0, 13); t[14] = CAND(0, 14); t[15] = CAND(0, 15);
        SORT16(t);
        x[0] = CAND(1, 0); x[1] = CAND(1, 1); x[2] = CAND(1, 2); x[3] = CAND(1, 3); x[4] = CAND(1, 4); x[5] = CAND(1, 5); x[6] = CAND(1, 6); x[7] = CAND(1, 7);
        x[8] = CAND(2, 0); x[9] = CAND(2, 1); x[10] = CAND(2, 2); x[11] = CAND(2, 3); x[12] = CAND(2, 4); x[13] = CAND(3, 0); x[14] = CAND(3, 1); x[15] = CAND(3, 2);
        SORT16(x); MERGE16(t, x);
        x[0] = CAND(3, 3); x[1] = CAND(4, 0); x[2] = CAND(4, 1); x[3] = CAND(4, 2); x[4] = CAND(5, 0); x[5] = CAND(5, 1); x[6] = CAND(6, 0); x[7] = CAND(6, 1);
        x[8] = CAND(7, 0); x[9] = CAND(7, 1); x[10] = CAND(8, 0); x[11] = CAND(9, 0); x[12] = CAND(10, 0); x[13] = CAND(11, 0); x[14] = CAND(12, 0); x[15] = CAND(13, 0);
        SORT16(x); MERGE16(t, x);
        { float y0 = CAND(14, 0); INS16(t, y0); float y1 = CAND(15, 0); INS16(t, y1); }
#undef CAND
        const float* ssp = (const float*)(F.ws + WS_SS) + row * 16; float ss = 0.f;
#pragma unroll
        for (int q = 0; q < 4; ++q) { const f32x4 v = *(const GAS f32x4*)(ssp + 4 * q); ss += (v.x + v.y) + (v.z + v.w); }
        const float r2 = 1.f / sqrtf(ss * (1.f / D) + NORM_EPS);
        const float kq = r2 * 1.4426950408889634f; const float v0 = __uint_as_float(__float_as_uint(t[0]) & ~0xffu);
        float g[16]; float gs = 0.f;
#pragma unroll
        for (int q = 0; q < 16; ++q) { const float v = __uint_as_float(__float_as_uint(t[q]) & ~0xffu); g[q] = __builtin_amdgcn_exp2f((v - v0) * kq); gs += g[q]; }
        const float gi = 1.f / gs;
        int* IDX = (int*)(F.ws + WS_IDX) + row * 128 + head * 16; float* G = (float*)(F.ws + WS_G) + row * 128 + head * 16;
#pragma unroll
        for (int q = 0; q < 4; ++q) { int e[4];
#pragma unroll
            for (int z = 0; z < 4; ++z) { const unsigned ij = __float_as_uint(t[4 * q + z]) & 0xffu; const unsigned e1 = __float_as_uint(pa[ij >> 4]) & 0x7fu, e2 = __float_as_uint(pb[ij & 15]) & 0x7fu; e[z] = (int)(e1 * 128u + e2); }
            *(GAS v4u*)(IDX + 4 * q) = (v4u){(unsigned)e[0], (unsigned)e[1], (unsigned)e[2], (unsigned)e[3]};
            *(GAS f32x4*)(G + 4 * q) = (f32x4){g[4 * q] * gi, g[4 * q + 1] * gi, g[4 * q + 2] * gi, g[4 * q + 3] * gi}; }
    }
    __syncthreads();
}

#define DPP_F(x, ctrl) __uint_as_float((unsigned)__builtin_amdgcn_update_dpp(0, (int)__float_as_uint(x), ctrl, 0xf, 0xf, false))
#define DPP_I(x, ctrl) __builtin_amdgcn_update_dpp(0, (x), ctrl, 0xf, 0xf, false)
#define DPP_HALF_MIRROR 0x141
#define DPP_XOR2 0x4E
#define DPP_XOR1 0xB1
#define DPP_ROR8 0x128
typedef float f32x2p __attribute__((ext_vector_type(2)));
typedef _Float16 h16x2 __attribute__((ext_vector_type(2)));
typedef __bf16 b16x2 __attribute__((ext_vector_type(2)));
#define FP8X2(w, hi) __builtin_amdgcn_cvt_pk_f32_fp8((int)(w), hi)
__device__ __forceinline__ void p6_tail(Frame& F, const Args& args) {
    const int lane = F.lane, j = blockIdx.x & 7, gwv = (blockIdx.x >> 3) * NWAVES + F.wave, sg = lane >> 3, cg = lane & 7;
    const int tok0 = j * 2048 + gwv * 8;
    constexpr size_t SLICE = (size_t)NEXP * 128;
    const unsigned char* U8 = F.ws + WS_U8; const unsigned char* V8 = F.ws + WS_V8; const unsigned loff = 16u * cg;
    int i0[8], i1[8];
#pragma unroll
    for (int tk = 0; tk < 8; ++tk) { const int* ip = (const int*)(F.ws + WS_IDX) + (size_t)(tok0 + tk) * 128 + lane; i0[tk] = ip[0]; i1[tk] = ip[64]; }
    v4u buf[16];
    unsigned nid[16];
#define T_IDS(tkn) do { _Pragma("unroll") for (int it_ = 0; it_ < 16; ++it_) nid[it_] = (unsigned)__shfl(it_ < 8 ? i0[tkn] : i1[tkn], (it_ & 7) * 8 + sg) * 128u + loff; } while (0)
#define T_LOAD(BASE, it) do { buf[it] = *(const GAS v4u*)((BASE) + nid[it]); } while (0)
    LAS unsigned char* hq = F.lds + RING_OFF + F.wave * 8192;
    float sh[8];
    {
        const unsigned char* a8 = F.ws + WS_A8 + (size_t)tok0 * D + 16 * lane; const float* sa2 = (const float*)(F.ws + WS_SA2) + tok0;
#pragma unroll
        for (int tk = 0; tk < 8; ++tk) { *(LAS v4u*)(hq + tk * 1024 + 16 * lane) = *(const GAS v4u*)(a8 + (size_t)tk * D); sh[tk] = sa2[tk]; }
    }
    float zz[8][2];
#pragma unroll
    for (int tk = 0; tk < 8; ++tk) { zz[tk][0] = 0.f; zz[tk][1] = 0.f; }
    {
        { const unsigned char* b0 = U8 + (size_t)j * SLICE; T_IDS(0);
#pragma unroll
          for (int it = 0; it < 16; ++it) T_LOAD(b0, it); }
        for (int s = 0; s < 8; ++s) {
            const int sl = (j + s) & 7, sln = (sl + 1) & 7;
            const unsigned char* bcur = U8 + (size_t)sl * SLICE; const unsigned char* bnxt = U8 + (size_t)sln * SLICE;
#define U_STEP(tk) do { constexpr int tn = ((tk) + 1) & 7; const unsigned char* nb = ((tk) == 7) ? bnxt : bcur; \
            T_IDS(tn); \
            const v4u hb = *(const LAS v4u*)(hq + (tk) * 1024 + 128 * sl + 16 * cg);        \
            int part[16];                                                                     \
            _Pragma("unroll") for (int it = 0; it < 16; ++it) { \
                asm volatile("" : "+v"(buf[it])); \
                int a0 = __builtin_amdgcn_sdot4((int)buf[it][0], (int)hb[0], 0, false); a0 = __builtin_amdgcn_sdot4((int)buf[it][1], (int)hb[1], a0, false); \
                a0 = __builtin_amdgcn_sdot4((int)buf[it][2], (int)hb[2], a0, false); a0 = __builtin_amdgcn_sdot4((int)buf[it][3], (int)hb[3], a0, false); \
                part[it] = a0; asm volatile("" : "+v"(part[it])); \
                T_LOAD(nb, it); } \
            int p8[8], p4[4], p2[2]; \
            { const bool up = (lane & 4) != 0; _Pragma("unroll") for (int e = 0; e < 8; ++e) { const int snd = up ? part[e] : part[e + 8], kp = up ? part[e + 8] : part[e]; p8[e] = kp + DPP_I(snd, DPP_HALF_MIRROR); } }     \
            { const bool up = (lane & 2) != 0; _Pragma("unroll") for (int e = 0; e < 4; ++e) { const int snd = up ? p8[e] : p8[e + 4], kp = up ? p8[e + 4] : p8[e]; p4[e] = kp + DPP_I(snd, DPP_XOR2); } } \
            { const bool up = (lane & 1) != 0; _Pragma("unroll") for (int e = 0; e < 2; ++e) { const int snd = up ? p4[e] : p4[e + 2], kp = up ? p4[e + 2] : p4[e]; p2[e] = kp + DPP_I(snd, DPP_XOR1); } } \
            zz[tk][0] += (float)p2[0]; zz[tk][1] += (float)p2[1];                            \
            } while (0)
            U_STEP(0); U_STEP(1); U_STEP(2); U_STEP(3); U_STEP(4); U_STEP(5); U_STEP(6); U_STEP(7);
#undef U_STEP
        }
    }
    {
        const float* SU = (const float*)(F.ws + WS_SU); const float* SV = (const float*)(F.ws + WS_SV);
#pragma unroll
        for (int tk = 0; tk < 8; ++tk) {
            const float* ssp = (const float*)(F.ws + WS_SS) + (size_t)(tok0 + tk) * 16; float ss = 0.f;
#pragma unroll
            for (int q = 0; q < 4; ++q) { const f32x4 v = *(const GAS f32x4*)(ssp + 4 * q); ss += (v.x + v.y) + (v.z + v.w); }
            const float r2 = 1.f / sqrtf(ss * (1.f / D) + NORM_EPS);
#pragma unroll
            for (int e = 0; e < 2; ++e) { const int slot = (2 * cg + e) * 8 + sg;
                const int ida = __shfl(i0[tk], slot & 63), idb = __shfl(i1[tk], slot & 63); const int id = cg < 4 ? ida : idb;
                const float g = ((const float*)(F.ws + WS_G))[(size_t)(tok0 + tk) * 128 + slot];
                zz[tk][e] = g * gelu_exact(r2 * sh[tk] * SU[id] * zz[tk][e]) * SV[id]; }
        }
    }
    float ssq[8];
    LAS v4u* cqL = (LAS v4u*)(F.lds + RING_OFF + 65536 + F.wave * 8192); float scv[8];
#pragma unroll
    for (int tk = 0; tk < 8; ++tk) {
        float am = fmaxf(fabsf(zz[tk][0]), fabsf(zz[tk][1]));
#pragma unroll
        for (int o = 1; o < 64; o <<= 1) am = fmaxf(am, __shfl_xor(am, o));
        const float sc = am > 0.f ? am * (1.f / 127.f) : 1.f, inv = 1.f / sc;
        scv[tk] = sc;
        const int q0 = __float2int_rn(zz[tk][0] * inv) & 255, q1 = __float2int_rn(zz[tk][1] * inv) & 255;
        v4u wq;
#pragma unroll
        for (int g = 0; g < 4; ++g) { unsigned w = 0u;
#pragma unroll
            for (int b = 0; b < 4; ++b) { const int it = 4 * g + b; w |= (unsigned)__shfl((it & 1) ? q1 : q0, sg * 8 + (it >> 1)) << (8 * b); }
            wq[g] = w; }
        cqL[tk * 64 + lane] = wq;
    }
    for (int vrep_ = 0; vrep_ < ((REP_PHASE == 31) ? 3 : 1); ++vrep_)
    {
#pragma unroll
    for (int tk = 0; tk < 8; ++tk) ssq[tk] = 0.f;
        float* XO = F.out + (size_t)tok0 * D + 16 * cg + 2 * sg;
        const unsigned char* XB = F.ws + WS_A8 + (size_t)tok0 * D + 16 * cg + 2 * sg;
        unsigned xC, xN;
        xC = *(const GAS unsigned short*)(XB + 128 * j);
        { const unsigned char* b0 = V8 + (size_t)j * SLICE; T_IDS(0);
#pragma unroll
          for (int it = 0; it < 16; ++it) T_LOAD(b0, it); }
        for (int s = 0; s < 8; ++s) {
            const int sl = (j + s) & 7, sln = (sl + 1) & 7;
            const unsigned char* bcur = V8 + (size_t)sl * SLICE; const unsigned char* bnxt = V8 + (size_t)sln * SLICE;
#define V_STEP(tk) do { constexpr int tn = ((tk) + 1) & 7; const int slq = ((tk) == 7) ? sln : sl; const unsigned char* nb = ((tk) == 7) ? bnxt : bcur; \
            T_IDS(tn); \
            xN = *(const GAS unsigned short*)(XB + (size_t)tn * D + 128 * slq); \
            const v4u cqv = cqL[(tk) * 64 + lane]; \
            int ai[16]; \
            _Pragma("unroll") for (int e = 0; e < 16; ++e) ai[e] = 0; \
            _Pragma("unroll") for (int g = 0; g < 4; ++g) { \
                asm volatile("" : "+v"(buf[4 * g]), "+v"(buf[4 * g + 1]), "+v"(buf[4 * g + 2]), "+v"(buf[4 * g + 3])); \
                const int cq_ = (int)cqv[g]; \
                _Pragma("unroll") for (int z = 0; z < 4; ++z) { const unsigned R0 = buf[4 * g][z], R1 = buf[4 * g + 1][z], R2 = buf[4 * g + 2][z], R3 = buf[4 * g + 3][z]; \
                    const unsigned l01 = __builtin_amdgcn_perm(R1, R0, 0x05010400u), h01 = __builtin_amdgcn_perm(R1, R0, 0x07030602u), l23 = __builtin_amdgcn_perm(R3, R2, 0x05010400u), h23 = __builtin_amdgcn_perm(R3, R2, 0x07030602u); \
                    ai[4 * z]     = __builtin_amdgcn_sdot4((int)__builtin_amdgcn_perm(l23, l01, 0x05040100u), cq_, ai[4 * z], false); \
                    ai[4 * z + 1] = __builtin_amdgcn_sdot4((int)__builtin_amdgcn_perm(l23, l01, 0x07060302u), cq_, ai[4 * z + 1], false); \
                    ai[4 * z + 2] = __builtin_amdgcn_sdot4((int)__builtin_amdgcn_perm(h23, h01, 0x05040100u), cq_, ai[4 * z + 2], false); \
                    ai[4 * z + 3] = __builtin_amdgcn_sdot4((int)__builtin_amdgcn_perm(h23, h01, 0x07060302u), cq_, ai[4 * z + 3], false); } \
                asm volatile("" : "+v"(ai[0]), "+v"(ai[1]), "+v"(ai[2]), "+v"(ai[3]), "+v"(ai[4]), "+v"(ai[5]), "+v"(ai[6]), "+v"(ai[7])); \
                asm volatile("" : "+v"(ai[8]), "+v"(ai[9]), "+v"(ai[10]), "+v"(ai[11]), "+v"(ai[12]), "+v"(ai[13]), "+v"(ai[14]), "+v"(ai[15])); \
                T_LOAD(nb, 4 * g); T_LOAD(nb, 4 * g + 1); T_LOAD(nb, 4 * g + 2); T_LOAD(nb, 4 * g + 3); } \
            int r8[8], r4[4], r2[2];                                                         \
            _Pragma("unroll") for (int e = 0; e < 8; ++e) { const auto w_ = __builtin_amdgcn_permlane32_swap((unsigned)ai[e], (unsigned)ai[e + 8], false, false); r8[e] = (int)(w_[0] + w_[1]); } \
            _Pragma("unroll") for (int e = 0; e < 4; ++e) { const auto w_ = __builtin_amdgcn_permlane16_swap((unsigned)r8[e], (unsigned)r8[e + 4], false, false); r4[e] = (int)(w_[0] + w_[1]); } \
            { const bool up = (lane & 8) != 0; _Pragma("unroll") for (int e = 0; e < 2; ++e) { const int snd = up ? r4[e] : r4[e + 2], kp = up ? r4[e + 2] : r4[e]; r2[e] = kp + DPP_I(snd, DPP_ROR8); } } \
            const unsigned xb_ = xC ^ 0x8080u;                                                \
            f32x2p x_ = {((float)(xb_ & 0xffu) - 128.f) * sh[tk] + (float)r2[0] * scv[tk], ((float)((xb_ >> 8) & 0xffu) - 128.f) * sh[tk] + (float)r2[1] * scv[tk]}; \
            *(GAS f32x2p*)(XO + (size_t)(tk) * D + 128 * sl) = x_; \
            ssq[tk] += x_.x * x_.x + x_.y * x_.y; \
            xC = xN; } while (0)
            V_STEP(0); V_STEP(1); V_STEP(2); V_STEP(3); V_STEP(4); V_STEP(5); V_STEP(6); V_STEP(7);
#undef V_STEP
        }
    }
#undef T_LOAD
#undef T_IDS
    asm volatile("s_waitcnt vmcnt(0)" ::: "memory");
    {
        const GAS f32x4* wr = (const GAS f32x4*)args.in[19] + lane;
#pragma unroll
        for (int tk = 0; tk < 8; ++tk) {
            const float rf = 1.f / sqrtf(wave_sum(ssq[tk]) * (1.f / D) + NORM_EPS);
            GAS f32x4* xr = (GAS f32x4*)(F.out + (size_t)(tok0 + tk) * D) + lane;
#pragma unroll
            for (int q = 0; q < 4; ++q) { const f32x4 v = __builtin_nontemporal_load(xr + 64 * q); const f32x4 g = wr[64 * q]; xr[64 * q] = (f32x4){v.x * rf * g.x, v.y * rf * g.y, v.z * rf * g.z, v.w * rf * g.w}; }
        }
    }
}

__global__ void __launch_bounds__(NWAVES * 64, 2) hymba_fwd(Args args) {
    extern __shared__ __attribute__((aligned(16))) unsigned char lds[];
#if USE_CG_SYNC
    cg::grid_group grid = cg::this_grid();
#endif
    Frame F;
    F.lds = (LAS unsigned char*)lds;
    frame_refresh(F);
    F.G = gridDim.x; { const int bx = blockIdx.x; F.vcu = (F.G % 8 == 0) ? (bx % 8) * (F.G / 8) + bx / 8 : bx; }
    F.out = args.out; F.ws = args.ws;
    unsigned char* ws = args.ws;
#if USE_CG_SYNC
#define GRID_SYNC() grid.sync()
#else
    for (int u = F.tid; u < (LDS_BYTES - LDSCTL_OFF) / 4; u += NWAVES * 64) ((LAS unsigned*)(F.lds + LDSCTL_OFF))[u] = 0u;
    __syncthreads();
    const XcdBarrier bar = xcd_barrier_post((unsigned*)(ws + WS_CTL) + CW_BAR, (volatile LAS unsigned*)(F.lds + MISC_OFF) + 8);
#define GRID_SYNC() xcd_barrier(bar)
#endif

    for (int rep_ = 0; rep_ < NREP(10); ++rep_) { p0_prologue(F, args); GRID_SYNC(); }

    {
        pg8::Gemm g{(const pg8::bf16_t*)(ws + WS_XN), (const pg8::bf16_t*)(ws + WS_WIN), M, NIN, D / 2};
        pg8::StaticOrder S; S.init(M, NIN, F.G, (int)blockIdx.x);
        pg8::EpiInProj E{(pg8::bf16_t*)(ws + WS_Q), (pg8::bf16_t*)(ws + WS_K), (const float*)(ws + WS_ROPE), attn_body::C2, (float*)(ws + WS_LNS), (const float*)(ws + WS_SA), (const float*)(ws + WS_SB)};
        static_assert(WS_V == WS_K + 16 * MiB && WS_U == WS_V + 16 * MiB && WS_VG == WS_U + 16 * MiB, "K|V|U|VG contiguous");
        for (int rep_ = 0; rep_ < NREP(11); ++rep_) { pg8::gemm_phase<pg8::EpiInProj, pg8::StaticOrder, true, true, true>(F.lds + RING_OFF, g, S, E);
            if (blockIdx.x >= 128) { frame_refresh(F); const float* fw = args.in[14] + 16 * F.lane; const f32x4 fw4[4] = {*(const GAS f32x4*)fw, *(const GAS f32x4*)(fw + 4), *(const GAS f32x4*)(fw + 8), *(const GAS f32x4*)(fw + 12)};
                for (int r = ((int)blockIdx.x - 128) * NWAVES + F.wave; r < NEXP; r += 128 * NWAVES) int8_table_row(F, args, r, fw4); }
            GRID_SYNC(); }
    }

    frame_refresh(F);
    {
        for (int rep_ = 0; rep_ < NREP(12); ++rep_) for (int it = F.vcu; it < 256; it += F.G) sgu_item(F, args, it >> 1, it & 1);
        float s1 = 0.f, s2 = 0.f;
#pragma unroll 4
        for (int i = 0; i < 32; ++i) { s1 += args.in[3][i] * args.in[4][i]; s2 += args.in[5][i] * args.in[6][i]; }
        const float lam = __uint_as_float(__builtin_amdgcn_readfirstlane(__float_as_uint(expf(s1) - expf(s2) + 0.2f)));
        const attn_body::AttnTensors AT{(const attn_body::bf16*)(ws + WS_Q), (const attn_body::bf16*)(ws + WS_K), (const attn_body::bf16*)(ws + WS_V), (attn_body::bf16*)(ws + WS_MIX)};
        const attn_body::StaticOrder S((int)F.G, (int)blockIdx.x);
        for (int rep_ = 0; rep_ < NREP(13); ++rep_) attn_body::attn_phase<attn_body::StaticOrder>((char*)lds + RING_OFF, AT, S, lam, args.in[7]);
    }
    GRID_SYNC();

    {
        pg8::Gemm g{(const pg8::bf16_t*)(ws + WS_MIX), (const pg8::bf16_t*)(ws + WS_WO), M, D, D};
        pg8::StaticOrder S; S.init(M, D, F.G, (int)blockIdx.x);
        pg8::EpiOutProj E{args.in[0], F.out, (pg8::bf16_t*)(ws + WS_X1B), (float*)(ws + WS_SS), (unsigned*)(ws + WS_PM), (LAS float*)(F.lds + RING_BYTES), ws + WS_A8, (float*)(ws + WS_SA2)};
        for (int rep_ = 0; rep_ < NREP(14); ++rep_) { pg8::gemm_phase<pg8::EpiOutProj, pg8::StaticOrder, true, true>(F.lds + RING_OFF, g, S, E); GRID_SYNC(); }
    }

#if STAGE >= 9
    {
        pg8::Gemm g{(const pg8::bf16_t*)(ws + WS_A8), (const pg8::bf16_t*)(ws + WS_WQ), M, NQP, D / 2};
        pg8::StaticOrder S; S.init(M, NQP, F.G, (int)blockIdx.x);
        pg8::EpiDq8 E{(pg8::bf16_t*)(ws + WS_QP), NQP, (const float*)(ws + WS_SA2), (const float*)(ws + WS_SBQ)};
        for (int rep_ = 0; rep_ < NREP(15); ++rep_) { pg8::gemm_phase<pg8::EpiDq8, pg8::StaticOrder, true, true, true>(F.lds + RING_OFF, g, S, E); GRID_SYNC(); }
    }

    frame_refresh(F);
    for (int rep_ = 0; rep_ < NREP(16); ++rep_) { p5_unit(F, (int)(blockIdx.x & 7) * 2048 + (int)(blockIdx.x >> 3) * 64); asm volatile("s_waitcnt vmcnt(0)" ::: "memory"); __syncthreads(); }
#endif

    frame_refresh(F);
    p6_tail(F, args);
}

extern "C" void kernel_launch(void* const* d_in, const int* in_sizes, int n_in, void* d_out, int out_size, void* d_ws, size_t ws_size, hipStream_t stream) {
    static int grid = 0;
    if (grid == 0) {
        if (n_in != 20 || in_sizes[0] != M * D || out_size != M * D || ws_size < WS_END) { fprintf(stderr, "kernel_launch: unexpected shapes (n_in %d, in0 %d, out %d, ws %zu)\n", n_in, n_in > 0 ? in_sizes[0] : -1, out_size, ws_size); grid = -1; return; }
        int dev = 0, cus = 0, per_cu = 0;
        if (hipGetDevice(&dev) != hipSuccess || hipDeviceGetAttribute(&cus, hipDeviceAttributeMultiprocessorCount, dev) != hipSuccess) { grid = -1; return; }
        if (hipFuncSetAttribute((const void*)hymba_fwd, hipFuncAttributeMaxDynamicSharedMemorySize, LDS_BYTES) != hipSuccess) { fprintf(stderr, "kernel_launch: hipFuncSetAttribute failed\n"); grid = -1; return; }
        if (hipOccupancyMaxActiveBlocksPerMultiprocessor(&per_cu, (const void*)hymba_fwd, NWAVES * 64, LDS_BYTES) != hipSuccess || per_cu < 1) { fprintf(stderr, "kernel_launch: occupancy query says %d blocks per CU\n", per_cu); per_cu = 1; }
        (void)hipGetLastError();
        grid = cus;
        if (grid != 256) { fprintf(stderr, "kernel_launch: this kernel's PEER phases need a 256-workgroup grid (256 CUs); device has %d\n", cus); grid = -1; return; }
    }
    if (grid < 0) return;
    Args a{};
    for (int i = 0; i < 20; ++i) a.in[i] = (const float*)d_in[i];
    a.out = (float*)d_out; a.ws = (unsigned char*)d_ws;
#if USE_CG_SYNC
    void* kargs[] = {&a};
    const hipError_t e = hipLaunchCooperativeKernel((const void*)hymba_fwd, dim3(grid), dim3(NWAVES * 64), kargs, LDS_BYTES, stream);
    if (e != hipSuccess) fprintf(stderr, "kernel_launch: cooperative launch failed: %s (grid %d)\n", hipGetErrorString(e), grid);
#else
    if (hipMemsetAsync((char*)d_ws + WS_CTL, 0, 65536, stream) != hipSuccess) { fprintf(stderr, "kernel_launch: hipMemsetAsync failed\n"); return; }
    hipLaunchKernelGGL(hymba_fwd, dim3(grid), dim3(NWAVES * 64), LDS_BYTES, stream, a);
    const hipError_t e = hipPeekAtLastError();
    if (e != hipSuccess) fprintf(stderr, "kernel_launch: launch failed: %s (grid %d)\n", hipGetErrorName(e), grid);
#endif
}
```
